# Optimizing an MI355X kernel written in HIP

```python
import math
import numpy as np
import jax
import jax.numpy as jnp
from jax import lax

D_MODEL = 1024
BATCH = 16
SEQ = 2048
DEPTH = 4

CTX_LEN = 256
GRID_W = 64
N_GROUPS = 4
GROUP_W = D_MODEL // N_GROUPS
N_HEADS_GROUP = 4
HEAD_DIM = GROUP_W // N_HEADS_GROUP
GQA_KV_HEADS = 2
DIFF_QK_DIM = HEAD_DIM // 2
RWKV_DECAY_LORA = 32
RWKV_A_LORA = 32
RWKV_GATE_LORA = 64
D_FF = -(-8 * D_MODEL // (3 * 256)) * 256
BLOCK_Q = 128
RET_CHUNK = 128
ROPE_THETA = 10000.0
LN_EPS = 1e-5
QK_NORM_EPS = 1e-6
RWKV_GN_EPS = 64e-5
ADA_INIT = 0.5
DEEPNORM_ALPHA = (2 * DEPTH) ** 0.25
DEEPNORM_BETA = (8 * DEPTH) ** -0.25

RWKV_SPLITS = (GROUP_W, GROUP_W, GROUP_W, 2 * RWKV_DECAY_LORA, 2 * RWKV_A_LORA, RWKV_GATE_LORA)
GQA_SPLITS = (GROUP_W, GQA_KV_HEADS * HEAD_DIM, GQA_KV_HEADS * HEAD_DIM)
DIFF_SPLITS = (GROUP_W, GROUP_W, GROUP_W)
RET_SPLITS = (GROUP_W, GROUP_W, GROUP_W, GROUP_W)
IN_SPLITS = (sum(RWKV_SPLITS), sum(GQA_SPLITS), sum(DIFF_SPLITS), sum(RET_SPLITS))
IN_W = sum(IN_SPLITS)

kernel_name = 'hybrid_rwkv7_gqa_diffattn_retention_dit'


def _split(t, sizes):
    idx = np.cumsum(sizes)[:-1].tolist()
    return jnp.split(t, idx, axis=-1)


def layer_norm(x, g, b, eps=LN_EPS):
    xf = x.astype(jnp.float32)
    mu = jnp.mean(xf, -1, keepdims=True)
    var = jnp.mean(jnp.square(xf - mu), -1, keepdims=True)
    return ((xf - mu) * lax.rsqrt(var + eps) * g + b).astype(x.dtype)


def head_norm(x, eps):
    xf = x.astype(jnp.float32)
    mu = jnp.mean(xf, -1, keepdims=True)
    var = jnp.mean(jnp.square(xf - mu), -1, keepdims=True)
    return (xf - mu) * lax.rsqrt(var + eps)


def rms_norm(x, g, eps=QK_NORM_EPS):
    xf = x.astype(jnp.float32)
    return (xf * lax.rsqrt(jnp.mean(jnp.square(xf), -1, keepdims=True) + eps) * g).astype(x.dtype)


def modulate(h, shift, scale):
    return h * (1.0 + scale) + shift


def grid_positions(T):
    rows = T // GRID_W
    row = jnp.repeat(jnp.arange(rows, dtype=jnp.int32), GRID_W)
    col = jnp.tile(jnp.arange(GRID_W, dtype=jnp.int32), rows)
    return row, col


def rope_1d(x, pos):
    n = x.shape[-1]
    half = n // 2
    inv = ROPE_THETA ** (-jnp.arange(half, dtype=jnp.float32) * 2.0 / n)
    ang = pos.astype(jnp.float32)[:, None] * inv[None, :]
    shape = (pos.shape[0],) + (1,) * (x.ndim - 3) + (half,)
    cos = jnp.cos(ang).reshape(shape)
    sin = jnp.sin(ang).reshape(shape)
    x1, x2 = x[..., :half], x[..., half:]
    return jnp.concatenate([x1 * cos - x2 * sin, x1 * sin + x2 * cos], -1).astype(x.dtype)


def rope_axial(x, row, col):
    h = x.shape[-1] // 2
    return jnp.concatenate([rope_1d(x[..., :h], row), rope_1d(x[..., h:], col)], -1)


def query_blocks(fn, q):
    B, T = q.shape[:2]
    nb = T // BLOCK_Q
    qb = jnp.moveaxis(q.reshape((B, nb, BLOCK_Q) + q.shape[2:]), 1, 0)
    ob = lax.map(fn, qb)
    return jnp.moveaxis(ob, 0, 1).reshape((B, T) + ob.shape[3:])


def centred_shift(p, mu):
    zero = jnp.zeros_like(p[:, :1])
    nb = 0.5 * (jnp.concatenate([zero, p[:, :-1]], 1) + jnp.concatenate([p[:, 1:], zero], 1))
    return p + mu * (nb - p)


def rwkv7_scan(r, w, k, v, a, b, s0):
    xs = tuple(jnp.moveaxis(t.astype(jnp.float32), 2, 0) for t in (r, w, k, v, a, b))

    def step(s, inp):
        r_t, w_t, k_t, v_t, a_t, b_t = inp
        sa = jnp.einsum('dbhvk,dbhk->dbhv', s, a_t)
        s = s * w_t[..., None, :] + sa[..., :, None] * b_t[..., None, :] + v_t[..., :, None] * k_t[..., None, :]
        y = jnp.einsum('dbhvk,dbhk->dbhv', s, r_t)
        return s, y

    s_fin, ys = lax.scan(step, s0, xs)
    return jnp.moveaxis(ys, 0, 2), s_fin


def rwkv_mixer(p, prm, s0):
    w0, w_up, a0, a_up, g_up, k_k, k_a, r_k, ln_g, ln_b = prm
    B, T, _ = p.shape
    H, N = N_HEADS_GROUP, HEAD_DIM
    pr, pk, pv, pw, pa, pg = _split(p, RWKV_SPLITS)
    w = w0 + jnp.einsum('btdr,drc->btdc', jnp.tanh(pw.reshape(B, T, 2, RWKV_DECAY_LORA)), w_up)
    decay = jnp.exp(-jnp.exp((-jax.nn.softplus(-w) - 0.5).astype(jnp.float32)))
    a = jax.nn.sigmoid(a0 + jnp.einsum('btdr,drc->btdc', pa.reshape(B, T, 2, RWKV_A_LORA), a_up))
    g = jax.nn.sigmoid(pg) @ g_up
    kk = (pk * k_k).reshape(B, T, H, N).astype(jnp.float32)
    kk = kk / jnp.maximum(jnp.linalg.norm(kk, axis=-1, keepdims=True), 1e-12)
    k_dir = pk[:, :, None, :] * (1.0 + (a - 1.0) * k_a)
    both = lambda t: jnp.stack([t, jnp.flip(t, 1)])
    per_dir = lambda t: jnp.stack([t[:, :, 0], jnp.flip(t[:, :, 1], 1)]).reshape(2, B, T, H, N)
    r_d = both(pr.reshape(B, T, H, N))
    v_d = both(pv.reshape(B, T, H, N))
    kk_d = both(kk)
    w_d, k_d, a_d = per_dir(decay), per_dir(k_dir), per_dir(a)
    y_d, s_fin = rwkv7_scan(r_d, w_d, k_d, v_d, -kk_d, kk_d * a_d, s0)
    bonus = jnp.sum(r_d * k_d * r_k, -1, keepdims=True) * v_d
    y = y_d[0] + jnp.flip(y_d[1], 1)
    bonus = bonus[0] + jnp.flip(bonus[1], 1)
    out = head_norm(y, RWKV_GN_EPS).reshape(B, T, GROUP_W) * ln_g + ln_b
    out = (out + bonus.reshape(B, T, GROUP_W)) * g
    return out, s_fin


def retention_dir(q, k, v, gamma, s0):
    B, T, H, dk = q.shape
    C = RET_CHUNK
    nc = T // C
    lg = jnp.log(gamma)
    qc = q.reshape(B, nc, C, H, dk).astype(jnp.float32)
    kc = k.reshape(B, nc, C, H, dk).astype(jnp.float32)
    vc = v.reshape(B, nc, C, H, -1).astype(jnp.float32)
    i = jnp.arange(C, dtype=jnp.float32)
    dif = i[:, None] - i[None, :]
    dmat = jnp.where(dif >= 0, jnp.exp(jnp.maximum(dif, 0.0)[None] * lg[:, None, None]), 0.0)
    intra = jnp.einsum('bnhij,bnjhe->bnihe', jnp.einsum('bnihd,bnjhd->bnhij', qc, kc) * dmat, vc)
    k_dec = kc * jnp.exp((C - 1.0 - i)[:, None] * lg[None, :])[:, :, None]
    kv = jnp.einsum('bnjhd,bnjhe->nbhde', k_dec, vc)
    g_chunk = jnp.exp(C * lg)[None, :, None, None]

    def step(R, kv_n):
        return g_chunk * R + kv_n, R

    s_fin, Rs = lax.scan(step, s0, kv)
    q_dec = qc * jnp.exp((i + 1.0)[:, None] * lg[None, :])[:, :, None]
    inter = jnp.einsum('bnihd,nbhde->bnihe', q_dec, Rs)
    return (intra + inter).reshape(B, T, H, -1), s_fin


def retention_mixer(p, pos, s0):
    B, T, _ = p.shape
    H, N = N_HEADS_GROUP, HEAD_DIM
    pq, pk, pv, pg = _split(p, RET_SPLITS)
    q = pq.reshape(B, T, H, N)
    k = pk.reshape(B, T, H, N)
    v = pv.reshape(B, T, H, N)
    if pos is not None:
        q = rope_1d(q, pos)
        k = rope_1d(k, pos)
    k = k * N ** -0.5
    gam_f = 1.0 - 2.0 ** (-5.0 - jnp.arange(H, dtype=jnp.float32))
    gam_b = gam_f[::-1]
    o_f, s_f = retention_dir(q, k, v, gam_f, s0[0])
    o_b, s_b = retention_dir(jnp.flip(q, 1), jnp.flip(k, 1), jnp.flip(v, 1), gam_b, s0[1])
    o = head_norm(o_f + jnp.flip(o_b, 1), LN_EPS).reshape(B, T, GROUP_W)
    return jax.nn.silu(pg) * o, (s_f, s_b)


def gqa_heads(pq, pk, pv, qn, kn, row, col):
    B, T, _ = pq.shape
    q = rms_norm(pq.reshape(B, T, N_HEADS_GROUP, HEAD_DIM), qn)
    k = rms_norm(pk.reshape(B, T, GQA_KV_HEADS, HEAD_DIM), kn)
    v = pv.reshape(B, T, GQA_KV_HEADS, HEAD_DIM)
    if row is not None:
        q = rope_axial(q, row, col)
        k = rope_axial(k, row, col)
    return q, k, v


def gqa_attend(q, k, v):
    B, Tq, H, d = q.shape
    hkv = k.shape[2]
    qg = q.reshape(B, Tq, hkv, H // hkv, d)
    s = jnp.einsum('bqhgd,bkhd->bhgqk', qg, k) * d ** -0.5
    p = jax.nn.softmax(s.astype(jnp.float32), axis=-1).astype(v.dtype)
    return jnp.einsum('bhgqk,bkhd->bqhgd', p, v).reshape(B, Tq, H, d)


def diff_heads(pq, pk, pv, row, col):
    B, T, _ = pq.shape
    q = pq.reshape(B, T, N_HEADS_GROUP, 2, DIFF_QK_DIM)
    k = pk.reshape(B, T, N_HEADS_GROUP, 2, DIFF_QK_DIM)
    v = pv.reshape(B, T, N_HEADS_GROUP, HEAD_DIM)
    if row is not None:
        q = rope_axial(q, row, col)
        k = rope_axial(k, row, col)
    return q, k, v


def diff_attend(q, k, v, lam):
    s = jnp.einsum('bqhmd,bkhmd->bhmqk', q, k) * DIFF_QK_DIM ** -0.5
    p = jax.nn.softmax(s.astype(jnp.float32), axis=-1)
    a = p[:, :, 0] - lam * p[:, :, 1]
    return jnp.einsum('bhqk,bkhe->bqhe', a.astype(v.dtype), v)


def swiglu(h, w1, w2):
    u, gt = jnp.split(h @ w1, 2, axis=-1)
    return (jax.nn.silu(u) * gt) @ w2


def setup_inputs(seed: int = 0) -> dict:
    key = jax.random.key(seed)
    ks = jax.random.split(key, 40)
    f32 = jnp.float32
    L, D, C = DEPTH, D_MODEL, GROUP_W
    nrm = lambda k, shape, s: s * jax.random.normal(k, shape, f32)
    near_one = lambda k, shape: 1.0 + 0.05 * jax.random.normal(k, shape, f32)
    return {
        'x': nrm(ks[0], (BATCH, SEQ, D), 1.0),
        'c': nrm(ks[1], (BATCH, D), 1.0),
        'ctx': nrm(ks[2], (BATCH, CTX_LEN, D), 1.0),
        'c_ctx': nrm(ks[3], (D,), 1.0),
        'ada_w': nrm(ks[4], (L, D, 6 * D), ADA_INIT * D ** -0.5),
        'ada_b': nrm(ks[5], (L, 6 * D), 0.02),
        'w_in': nrm(ks[6], (L, D, IN_W), D ** -0.5),
        'rwkv_mu': jax.random.uniform(ks[7], (L, IN_SPLITS[0]), f32),
        'rwkv_w0': jax.random.uniform(ks[8], (L, 2, C), f32, -6.5, -1.5),
        'rwkv_w_up': nrm(ks[9], (L, 2, RWKV_DECAY_LORA, C), 0.5 * RWKV_DECAY_LORA ** -0.5),
        'rwkv_a0': nrm(ks[10], (L, 2, C), 0.1),
        'rwkv_a_up': nrm(ks[11], (L, 2, RWKV_A_LORA, C), 0.5 * RWKV_A_LORA ** -0.5),
        'rwkv_g_up': nrm(ks[12], (L, RWKV_GATE_LORA, C), RWKV_GATE_LORA ** -0.5),
        'rwkv_k_k': 0.85 + nrm(ks[13], (L, C), 0.02),
        'rwkv_k_a': near_one(ks[14], (L, C)),
        'rwkv_r_k': nrm(ks[15], (L, N_HEADS_GROUP, HEAD_DIM), 0.1),
        'rwkv_ln_g': near_one(ks[16], (L, C)),
        'rwkv_ln_b': nrm(ks[17], (L, C), 0.02),
        'gqa_q_norm': near_one(ks[18], (L, HEAD_DIM)),
        'gqa_k_norm': near_one(ks[19], (L, HEAD_DIM)),
        'diff_lambda': nrm(ks[20], (L, 4, DIFF_QK_DIM), 0.1),
        'diff_norm': near_one(ks[21], (L, HEAD_DIM)),
        'w_out': nrm(ks[22], (L, N_GROUPS * GROUP_W, D), DEEPNORM_BETA * (N_GROUPS * GROUP_W) ** -0.5),
        'post1_g': near_one(ks[23], (L, D)),
        'post1_b': nrm(ks[24], (L, D), 0.02),
        'ffn_w_in': nrm(ks[25], (L, D, 2 * D_FF), D ** -0.5),
        'ffn_w_out': nrm(ks[26], (L, D_FF, D), DEEPNORM_BETA * D_FF ** -0.5),
        'post2_g': near_one(ks[27], (L, D)),
        'post2_b': nrm(ks[28], (L, D), 0.02),
    }


def reference(x, c, ctx, c_ctx, ada_w, ada_b, w_in, rwkv_mu, rwkv_w0, rwkv_w_up, rwkv_a0,
              rwkv_a_up, rwkv_g_up, rwkv_k_k, rwkv_k_a, rwkv_r_k, rwkv_ln_g, rwkv_ln_b,
              gqa_q_norm, gqa_k_norm, diff_lambda, diff_norm, w_out, post1_g, post1_b,
              ffn_w_in, ffn_w_out, post2_g, post2_b):
    B, S, D = x.shape
    H, N = N_HEADS_GROUP, HEAD_DIM
    row, col = grid_positions(S)
    pos = jnp.arange(S, dtype=jnp.int32)
    for l in range(DEPTH):
        need_ctx = l < DEPTH - 1
        mod = jax.nn.silu(c) @ ada_w[l] + ada_b[l]
        mod_c = jax.nn.silu(c_ctx) @ ada_w[l] + ada_b[l]
        sh1, sc1, g1, sh2, sc2, g2 = jnp.split(mod[:, None, :], 6, axis=-1)
        csh1, csc1, cg1, csh2, csc2, cg2 = jnp.split(mod_c, 6, axis=-1)
        p_x = modulate(x, sh1, sc1) @ w_in[l]
        p_c = modulate(ctx, csh1, csc1) @ w_in[l]
        rw_x, gq_x, df_x, rt_x = _split(p_x, IN_SPLITS)
        rw_c, gq_c, df_c, rt_c = _split(p_c, IN_SPLITS)

        rprm = (rwkv_w0[l], rwkv_w_up[l], rwkv_a0[l], rwkv_a_up[l], rwkv_g_up[l], rwkv_k_k[l],
                rwkv_k_a[l], rwkv_r_k[l], rwkv_ln_g[l], rwkv_ln_b[l])
        s0 = jnp.zeros((2, B, H, N, N), jnp.float32)
        y_rw_c, s_rw = rwkv_mixer(centred_shift(rw_c, rwkv_mu[l]), rprm, s0)
        y_rw_x, _ = rwkv_mixer(centred_shift(rw_x, rwkv_mu[l]), rprm, s_rw)

        qx, kx, vx = gqa_heads(*_split(gq_x, GQA_SPLITS), gqa_q_norm[l], gqa_k_norm[l], row, col)
        qc, kc, vc = gqa_heads(*_split(gq_c, GQA_SPLITS), gqa_q_norm[l], gqa_k_norm[l], None, None)
        k_all = jnp.concatenate([kc, kx], 1)
        v_all = jnp.concatenate([vc, vx], 1)
        y_gq_x = query_blocks(lambda qb: gqa_attend(qb, k_all, v_all), qx).reshape(B, S, GROUP_W)

        lam_init = 0.8 - 0.6 * math.exp(-0.3 * l)
        dl = diff_lambda[l].astype(jnp.float32)
        lam = jnp.exp(jnp.sum(dl[0] * dl[1])) - jnp.exp(jnp.sum(dl[2] * dl[3])) + lam_init
        dqx, dkx, dvx = diff_heads(*_split(df_x, DIFF_SPLITS), row, col)
        dqc, dkc, dvc = diff_heads(*_split(df_c, DIFF_SPLITS), None, None)
        dk_all = jnp.concatenate([dkc, dkx], 1)
        dv_all = jnp.concatenate([dvc, dvx], 1)
        y_df_x = query_blocks(lambda qb: diff_attend(qb, dk_all, dv_all, lam), dqx)
        y_df_x = (rms_norm(y_df_x, diff_norm[l]) * (1.0 - lam_init)).reshape(B, S, GROUP_W)

        r0 = (jnp.zeros((B, H, N, N), jnp.float32), jnp.zeros((B, H, N, N), jnp.float32))
        y_rt_c, s_rt = retention_mixer(rt_c, None, r0)
        y_rt_x, _ = retention_mixer(rt_x, pos, s_rt)

        y_x = jnp.concatenate([y_rw_x, y_gq_x, y_df_x, y_rt_x], -1) @ w_out[l]
        x = layer_norm(DEEPNORM_ALPHA * x + g1 * y_x, post1_g[l], post1_b[l])
        f_x = swiglu(modulate(x, sh2, sc2), ffn_w_in[l], ffn_w_out[l])
        x = layer_norm(DEEPNORM_ALPHA * x + g2 * f_x, post2_g[l], post2_b[l])

        if need_ctx:
            y_gq_c = gqa_attend(qc, kc, vc).reshape(B, CTX_LEN, GROUP_W)
            y_df_c = diff_attend(dqc, dkc, dvc, lam)
            y_df_c = (rms_norm(y_df_c, diff_norm[l]) * (1.0 - lam_init)).reshape(B, CTX_LEN, GROUP_W)
            y_c = jnp.concatenate([y_rw_c, y_gq_c, y_df_c, y_rt_c], -1) @ w_out[l]
            ctx = layer_norm(DEEPNORM_ALPHA * ctx + cg1 * y_c, post1_g[l], post1_b[l])
            f_c = swiglu(modulate(ctx, csh2, csc2), ffn_w_in[l], ffn_w_out[l])
            ctx = layer_norm(DEEPNORM_ALPHA * ctx + cg2 * f_c, post2_g[l], post2_b[l])
    return x
```

```cpp
#include <hip/hip_runtime.h>
#include <hip/hip_cooperative_groups.h>
#include <cstdio>
#ifndef PROBE
#define PROBE 0
#endif
#ifndef SCAN_PM
#define SCAN_PM 0
#endif
namespace cg = cooperative_groups;

typedef unsigned short u16;
using bf16x8 = __attribute__((ext_vector_type(8))) short;
using f32x16 = __attribute__((ext_vector_type(16))) float;
using u32x4 = __attribute__((ext_vector_type(4))) unsigned;
#define DI __device__ __forceinline__
#define MFMA32(a, b, c) __builtin_amdgcn_mfma_f32_32x32x16_bf16((a), (b), (c), 0, 0, 0)

static constexpr int D = 1024, NBATCH = 16, SEQ = 2048, CTX = 256, TALL = 2304, MALL = 36864, NL = 4;
static constexpr int INW = 3264, INWP = 3328, DFF = 2816;
static constexpr float ALPHA = 1.681792830507429f;
static constexpr float LOG2E = 1.4426950408889634f;
static constexpr int SMEM_BYTES = 79872;
static constexpr int NWCONV = 3200;

struct Params {
  const float *x, *c, *ctx, *c_ctx, *ada_w, *ada_b, *w_in, *rwkv_mu, *rwkv_w0, *rwkv_w_up, *rwkv_a0, *rwkv_a_up,
      *rwkv_g_up, *rwkv_k_k, *rwkv_k_a, *rwkv_r_k, *rwkv_ln_g, *rwkv_ln_b, *gqa_q_norm, *gqa_k_norm, *diff_lambda,
      *diff_norm, *w_out, *post1_g, *post1_b, *ffn_w_in, *ffn_w_out, *post2_g, *post2_b;
  float* out;
  unsigned* counters;
  unsigned* bar;
  unsigned* cucnt;
  float *lamv, *mod, *ropeA, *ropeD, *ropeR, *cbuf;
  u16 *w_in_t, *w_out_t, *ffn_in_t, *ffn_out_t;
  float* zctx;
  u16 *pbuf, *abuf;
  u16* yd;
  u16* vt;
  float* stats;
};

DI u16 f2bf(float x) { unsigned u = __float_as_uint(x); u += 0x7fffu + ((u >> 16) & 1u); return (u16)(u >> 16); }
DI float bf2f(u16 v) { return __uint_as_float(((unsigned)v) << 16); }
typedef __bf16 bf16v2 __attribute__((ext_vector_type(2)));
typedef float f32v2 __attribute__((ext_vector_type(2)));
DI unsigned pack2(float a, float b) { f32v2 v = {a, b}; bf16v2 r = __builtin_convertvector(v, bf16v2); return __builtin_bit_cast(unsigned, r); }
DI int opaque_tid() { int t = threadIdx.x; asm volatile("" : "+v"(t)); return t; }
DI int crow(int i, int h) { return (i & 3) + 8 * (i >> 2) + 4 * h; }
DI float dpp_f(float x, const int ctrl_sel) {
  int v = __float_as_int(x), r;
  if (ctrl_sel == 0) r = __builtin_amdgcn_update_dpp(0, v, 0xB1, 0xF, 0xF, true);
  else if (ctrl_sel == 1) r = __builtin_amdgcn_update_dpp(0, v, 0x4E, 0xF, 0xF, true);
  else r = __builtin_amdgcn_update_dpp(0, v, 0x141, 0xF, 0xF, true);
  return __int_as_float(r);
}
DI float xhalf_max(float x) {
  const auto r_ = __builtin_amdgcn_permlane32_swap(__float_as_uint(x), __float_as_uint(x), false, false);
  return fmaxf(__uint_as_float(r_[0]), __uint_as_float(r_[1]));
}
DI float xhalf_sum(float x) {
  const auto r_ = __builtin_amdgcn_permlane32_swap(__float_as_uint(x), __float_as_uint(x), false, false);
  return __uint_as_float(r_[0]) + __uint_as_float(r_[1]);
}
DI float reduce8(float x) { x += dpp_f(x, 0); x += dpp_f(x, 1); x += dpp_f(x, 2); return x; }
DI float wave_sum(float x) {
  x += dpp_f(x, 0); x += dpp_f(x, 1); x += dpp_f(x, 2);
  x += __int_as_float(__builtin_amdgcn_update_dpp(0, __float_as_int(x), 0x140, 0xF, 0xF, true));
  const int xi = __float_as_int(x);
  const float a = __int_as_float(__builtin_amdgcn_readlane(xi, 0)), b = __int_as_float(__builtin_amdgcn_readlane(xi, 16));
  const float c = __int_as_float(__builtin_amdgcn_readlane(xi, 32)), d = __int_as_float(__builtin_amdgcn_readlane(xi, 48));
  return (a + b) + (c + d);
}
DI float* xrow_ptr(const Params& P, int m) {
  int b = m / TALL, t = m - b * TALL;
  return t < CTX ? P.zctx + ((size_t)(b * CTX + t)) * D : P.out + ((size_t)(b * SEQ + t - CTX)) * D;
}


#define XB_TMO      128
#define XB_XCNT(j)  (256  + 64 * (j))
#define XB_XSUB(j)  (1280 + 64 * (j))
#define XB_XGEN(j)  (2304 + 64 * (j))
#define XB_TOP      3328
#define XB_TOPGEN   3392
#define XCD_BAR_WORDS 3456
#define XB_SPIN_CAP (1u << 20)
#define LAS __attribute__((address_space(3)))
DI unsigned xb_ld(unsigned* p) { return __hip_atomic_load(p, __ATOMIC_RELAXED, __HIP_MEMORY_SCOPE_AGENT); }
DI unsigned xb_add(unsigned* p, unsigned v) { return __hip_atomic_fetch_add(p, v, __ATOMIC_RELAXED, __HIP_MEMORY_SCOPE_AGENT); }
DI unsigned xb_xcc_id() { return (unsigned)__builtin_amdgcn_s_getreg((3 << 11) | 20) & 0xFu; }
#define XB_SPIN(cond, bar) do { unsigned _sp = 0; while (cond) { __builtin_amdgcn_s_sleep(1); \
    if ((++_sp & 255u) == 0u) { if (xb_ld(&(bar)[XB_TMO])) break; if (_sp > XB_SPIN_CAP) { atomicAdd(&(bar)[XB_TMO], 1u); break; } } } } while (0)
struct XcdBarrier { unsigned* bar; unsigned x; volatile LAS unsigned* st; };
DI XcdBarrier xcd_barrier_post(unsigned* bar, volatile LAS unsigned* st) {
  XcdBarrier b; b.bar = bar; b.x = xb_xcc_id(); b.st = st;
  if (threadIdx.x == 0) (void)xb_add(&bar[XB_XCNT(b.x)], 1u);
  return b;
}
DI void xcd_barrier_complete(unsigned* bar, unsigned x, unsigned& nloc, unsigned& nx) {
  const unsigned G = gridDim.x * gridDim.y * gridDim.z;
  unsigned sum, cnt, mine, sp = 0u;
  for (;;) {
    sum = 0u; cnt = 0u; mine = 0u;
#pragma unroll
    for (unsigned j = 0; j < 16; ++j) { const unsigned c = xb_ld(&bar[XB_XCNT(j)]); sum += c; cnt += (c > 0u) ? 1u : 0u; mine = (j == x) ? c : mine; }
    if (sum == G) break;
    __builtin_amdgcn_s_sleep(1);
    if ((++sp & 255u) == 0u) { if (xb_ld(&bar[XB_TMO])) break; if (sp > XB_SPIN_CAP) { atomicAdd(&bar[XB_TMO], 1u); break; } }
  }
  nloc = mine > 0u ? mine : 1u; nx = cnt > 0u ? cnt : 1u;
}
DI void xcd_barrier(const XcdBarrier& b) {
  asm volatile("s_waitcnt vmcnt(0)" ::: "memory");
  __syncthreads();
  if (threadIdx.x == 0) {
    unsigned* bar = b.bar;
    __builtin_amdgcn_s_waitcnt(0);
    unsigned nloc = b.st[0], nx = b.st[1];
    if (nloc == 0u) { xcd_barrier_complete(bar, b.x, nloc, nx); b.st[0] = nloc; b.st[1] = nx; }
    const unsigned old = xb_add(&bar[XB_XSUB(b.x)], 1u);
    const unsigned gen = old / nloc;
    if (old + 1u == (gen + 1u) * nloc) {
      __builtin_amdgcn_fence(__ATOMIC_RELEASE, "agent");
      asm volatile("s_waitcnt vmcnt(0)" ::: "memory");
      const unsigned og = xb_add(&bar[XB_TOP], 1u);
      const unsigned tg = og / nx;
      if (og + 1u == (tg + 1u) * nx) xb_add(&bar[XB_TOPGEN], 1u);
      else XB_SPIN(xb_ld(&bar[XB_TOPGEN]) == tg, bar);
      __builtin_amdgcn_fence(__ATOMIC_ACQUIRE, "agent");
      xb_add(&bar[XB_XGEN(b.x)], 1u);
      asm volatile("s_waitcnt vmcnt(0)" ::: "memory");
    } else {
      XB_SPIN(xb_ld(&bar[XB_XGEN(b.x)]) == gen, bar);
      __builtin_amdgcn_fence(__ATOMIC_ACQUIRE, "agent");
      asm volatile("s_waitcnt vmcnt(0)" ::: "memory");
    }
  }
  __syncthreads();
}

__device__ void wconv_tile(const Params& P, int l, int tile, unsigned char* smem) {
  float* T = (float*)smem;
  const int tid = opaque_tid();
  const float* src; u16* dst; int ldN, ldK, k0, n0; int kind;
  if (tile < 832) { kind = 0; int nt = tile >> 4, kt = tile & 15; src = P.w_in + (size_t)l * D * INW; ldN = INW; dst = P.w_in_t; ldK = D; k0 = kt * 64; n0 = nt * 64; }
  else if (tile < 1088) { kind = 1; int t = tile - 832; int nt = t >> 4, kt = t & 15; src = P.w_out + (size_t)l * D * D; ldN = D; dst = P.w_out_t; ldK = D; k0 = kt * 64; n0 = nt * 64; }
  else if (tile < 2496) { kind = 2; int t = tile - 1088; int nt = t >> 4, kt = t & 15; src = P.ffn_w_in + (size_t)l * D * (2 * DFF); ldN = 2 * DFF; dst = P.ffn_in_t; ldK = D; k0 = kt * 64; n0 = nt * 64; }
  else { kind = 3; int t = tile - 2496; int nt = t / 44, kt = t - nt * 44; src = P.ffn_w_out + (size_t)l * DFF * D; ldN = D; dst = P.ffn_out_t; ldK = DFF; k0 = kt * 64; n0 = nt * 64; }
  const int j = tid & 63, g = tid >> 6;
  int scol;
  bool zero = false;
  if (kind == 2) { int blk = n0 >> 7, w = (n0 >> 6) & 1; int hb = blk * 64 + w * 32; scol = (j < 32) ? hb + j : DFF + hb + (j - 32); }
  else { scol = n0 + j; if (kind == 0 && scol >= INW) zero = true; }
#pragma unroll 4
  for (int i = 0; i < 16; ++i) {
    int kr = g + 4 * i;
    T[kr * 65 + j] = zero ? 0.f : src[(size_t)(k0 + kr) * ldN + scol];
  }
  __syncthreads();
#pragma unroll 4
  for (int i = 0; i < 16; ++i) {
    int jr = g + 4 * i;
    dst[(size_t)(n0 + jr) * ldK + k0 + j] = f2bf(T[j * 65 + jr]);
  }
  __syncthreads();
}

__device__ void phase0(const Params& P, unsigned char* smem, int bid, int nb) {
  const int tid = opaque_tid();
  const int total = 384 + 256 + 1;
  for (int item = bid; item < total; item += nb) {
    if (item < 384) {
      const int l = item / 96, col0 = (item - l * 96) * 64;
      float* sc = (float*)smem;
      for (int i = tid; i < 17 * 1024; i += 256) {
        int r = i >> 10, k = i & 1023;
        float v = r < 16 ? P.c[r * 1024 + k] : P.c_ctx[k];
        sc[i] = v / (1.f + expf(-v));
      }
      __syncthreads();
      const int col = tid & 63, kq = tid >> 6;
      float acc[17];
#pragma unroll
      for (int r = 0; r < 17; ++r) acc[r] = 0.f;
      const float* w = P.ada_w + ((size_t)l * 1024 + kq * 256) * 6144 + col0 + col;
#pragma unroll 2
      for (int k = 0; k < 256; k += 4) {
        float w0 = w[(size_t)(k + 0) * 6144], w1 = w[(size_t)(k + 1) * 6144], w2 = w[(size_t)(k + 2) * 6144], w3 = w[(size_t)(k + 3) * 6144];
#pragma unroll
        for (int r = 0; r < 17; ++r) {
          float4 s = *(const float4*)(sc + r * 1024 + kq * 256 + k);
          acc[r] += s.x * w0 + s.y * w1 + s.z * w2 + s.w * w3;
        }
      }
      __syncthreads();
      float* red = (float*)smem;
#pragma unroll
      for (int r = 0; r < 17; ++r) red[(kq * 17 + r) * 64 + col] = acc[r];
      __syncthreads();
      for (int i = tid; i < 17 * 64; i += 256) {
        int r = i >> 6, cc = i & 63;
        float s = red[(0 * 17 + r) * 64 + cc] + red[(1 * 17 + r) * 64 + cc] + red[(2 * 17 + r) * 64 + cc] + red[(3 * 17 + r) * 64 + cc];
        P.mod[((size_t)(l * 17 + r)) * 6144 + col0 + cc] = s + P.ada_b[l * 6144 + col0 + cc];
      }
      __syncthreads();
    } else if (item < 384 + 256) {
      int e = (item - 384) * 256 + tid;
      int pos = e >> 5, i = e & 31;
      double inv = pow(10000.0, -2.0 * (double)i / 64.0);
      double ang = (double)pos * inv;
      P.ropeR[e * 2] = (float)cos(ang);
      P.ropeR[e * 2 + 1] = (float)sin(ang);
    } else {
      for (int e = tid; e < 64 * 16; e += 256) {
        int pos = e >> 4, i = e & 15;
        double ang = (double)pos * pow(10000.0, -2.0 * (double)i / 32.0);
        P.ropeA[e * 2] = (float)cos(ang); P.ropeA[e * 2 + 1] = (float)sin(ang);
      }
      for (int e = tid; e < 64 * 8; e += 256) {
        int pos = e >> 3, i = e & 7;
        double ang = (double)pos * pow(10000.0, -2.0 * (double)i / 16.0);
        P.ropeD[e * 2] = (float)cos(ang); P.ropeD[e * 2 + 1] = (float)sin(ang);
      }
      if (tid < NL) {
        const float* dl = P.diff_lambda + tid * 128;
        float s1 = 0.f, s2 = 0.f;
        for (int i = 0; i < 32; ++i) { s1 += dl[i] * dl[32 + i]; s2 += dl[64 + i] * dl[96 + i]; }
        float li = (float)(0.8 - 0.6 * exp(-0.3 * (double)tid));
        P.lamv[tid * 2] = expf(s1) - expf(s2) + li;
        P.lamv[tid * 2 + 1] = li;
      }
    }
  }
}

__device__ void phase_prep(const Params& P, int l, int mode, int bid, int nb, const int dummy = 0) {
  const int tid = opaque_tid();
  const int lane = tid & 63, wave = tid >> 6;
  const bool latent_only = (mode == 2) || (mode == 1 && l == NL - 1);
  const bool do_ln = !(mode == 0 && l == 0);
  const float* lg = P.post1_g; const float* lb = P.post1_b;
  if (mode == 0) { if (l > 0) { lg = P.post2_g + (l - 1) * D; lb = P.post2_b + (l - 1) * D; } }
  else if (mode == 1) { lg = P.post1_g + l * D; lb = P.post1_b + l * D; }
  else { lg = P.post2_g + (NL - 1) * D; lb = P.post2_b + (NL - 1) * D; }
  const int shofs = (mode == 0) ? 0 : 3 * D, scofs = shofs + D;
  const int mstep = nb * 4;
  int mn = bid * 4 + wave;
  while (mn < MALL && latent_only && (mn % TALL) < CTX) mn += mstep;
  float4 nv0 = make_float4(0.f, 0.f, 0.f, 0.f), nv1 = nv0, nv2 = nv0, nv3 = nv0;
  if (mn < MALL) {
    const int b = mn / TALL, t = mn - b * TALL; const bool isctx = t < CTX;
    const float* src = do_ln ? (isctx ? P.zctx + ((size_t)(b * CTX + t)) * D : P.out + ((size_t)(b * SEQ + t - CTX)) * D)
                             : (isctx ? P.ctx + ((size_t)(b * CTX + t)) * D : P.x + ((size_t)(b * SEQ + t - CTX)) * D);
    nv0 = *(const float4*)(src + lane * 4); nv1 = *(const float4*)(src + 256 + lane * 4); nv2 = *(const float4*)(src + 512 + lane * 4); nv3 = *(const float4*)(src + 768 + lane * 4);
  }
  while (mn < MALL) {
    const int m = mn;
    const int b = m / TALL, t = m - b * TALL;
    const bool isctx = t < CTX;
    float* xr = isctx ? P.zctx + ((size_t)(b * CTX + t)) * D : P.out + ((size_t)(b * SEQ + t - CTX)) * D;
    float4 v[4];
    v[0] = nv0; v[1] = nv1; v[2] = nv2; v[3] = nv3;
    mn += mstep;
    while (mn < MALL && latent_only && (mn % TALL) < CTX) mn += mstep;
    if (mn < MALL) {
      const int b2 = mn / TALL, t2 = mn - b2 * TALL; const bool c2 = t2 < CTX;
      const float* src = do_ln ? (c2 ? P.zctx + ((size_t)(b2 * CTX + t2)) * D : P.out + ((size_t)(b2 * SEQ + t2 - CTX)) * D)
                               : (c2 ? P.ctx + ((size_t)(b2 * CTX + t2)) * D : P.x + ((size_t)(b2 * SEQ + t2 - CTX)) * D);
      nv0 = *(const float4*)(src + lane * 4); nv1 = *(const float4*)(src + 256 + lane * 4); nv2 = *(const float4*)(src + 512 + lane * 4); nv3 = *(const float4*)(src + 768 + lane * 4);
    }
    float4 v0s[4];
    if (dummy) {
#pragma unroll
      for (int i = 0; i < 4; ++i) v0s[i] = v[i];
    }
    if (do_ln) {
      float s = 0.f;
#pragma unroll
      for (int i = 0; i < 4; ++i) s += v[i].x + v[i].y + v[i].z + v[i].w;
      const float mean = wave_sum(s) * (1.f / 1024.f);
      float q = 0.f;
#pragma unroll
      for (int i = 0; i < 4; ++i) { v[i].x -= mean; v[i].y -= mean; v[i].z -= mean; v[i].w -= mean; q += v[i].x * v[i].x + v[i].y * v[i].y + v[i].z * v[i].z + v[i].w * v[i].w; }
      const float rstd = rsqrtf(wave_sum(q) * (1.f / 1024.f) + 1e-5f);
      if (mode != 2 && lane == 0) *(float2*)(P.stats + (size_t)m * 2) = make_float2(mean, rstd);
#pragma unroll
      for (int i = 0; i < 4; ++i) {
        float4 g4 = *(const float4*)(lg + i * 256 + lane * 4), b4 = *(const float4*)(lb + i * 256 + lane * 4);
        v[i].x = v[i].x * rstd * g4.x + b4.x; v[i].y = v[i].y * rstd * g4.y + b4.y; v[i].z = v[i].z * rstd * g4.z + b4.z; v[i].w = v[i].w * rstd * g4.w + b4.w;
      }
    }
    if (dummy) {
#pragma unroll
      for (int i = 0; i < 4; ++i) { asm volatile("" :: "v"(v[i].x), "v"(v[i].y), "v"(v[i].z), "v"(v[i].w)); v[i] = v0s[i]; }
    }
    if (mode == 2 || dummy) {
#pragma unroll
      for (int i = 0; i < 4; ++i) *(float4*)(xr + i * 256 + lane * 4) = v[i];
    }
    if (mode != 2) {
      const int modrow = isctx ? 16 : b;
      const float* md = P.mod + ((size_t)(l * 17 + modrow)) * 6144;
#pragma unroll
      for (int i = 0; i < 4; ++i) {
        float4 sh = *(const float4*)(md + shofs + i * 256 + lane * 4), sc = *(const float4*)(md + scofs + i * 256 + lane * 4);
        uint2 o;
        o.x = pack2(v[i].x * (1.f + sc.x) + sh.x, v[i].y * (1.f + sc.y) + sh.y);
        o.y = pack2(v[i].z * (1.f + sc.z) + sh.z, v[i].w * (1.f + sc.w) + sh.w);
        *(uint2*)(P.abuf + (size_t)m * D + i * 256 + lane * 4) = o;
      }
    }
  }
}

enum { EPI_P = 0, EPI_RES1 = 1, EPI_RES2 = 2, EPI_SWIGLU = 3 };
template <int EPI, bool latent_only>
__device__ void phase_gemm(const Params& P, int l, const u16* __restrict__ A, const u16* __restrict__ Bt, const int K,
                           const int NT, unsigned char* smem, int bid, int nb, const int dummy = 0) {
  u16* sA = (u16*)smem;
  u16* sB = sA + 2 * 128 * 72;
  const int tid = opaque_tid(), lane = tid & 63, wave = tid >> 6, r = lane & 31, h = lane >> 5, wm = wave >> 1, wn = wave & 1;
  const int MT = latent_only ? 256 : 288;
  const int total = MT * NT, KT = K >> 6;
  const int lrow = tid >> 3, lkc = tid & 7;
  const bool swz = ((nb & 7) == 0);
  const int qstart = swz ? (bid >> 3) : bid, qstep = swz ? (nb >> 3) : nb, qtotal = swz ? (MT >> 3) * NT : total;
  for (int q = qstart; q < qtotal; q += qstep) {
    const int mq = q / NT, nt = q - mq * NT;
    const int mi_ = swz ? (mq * 8 + (bid & 7)) : mq;
    const int mt = latent_only ? ((mi_ >> 4) * 18 + 2 + (mi_ & 15)) : mi_;
    const int m0 = mt * 128, n0 = nt * 128;
    f32x16 acc[2][2];
#pragma unroll
    for (int a = 0; a < 2; ++a)
#pragma unroll
      for (int b = 0; b < 2; ++b)
#pragma unroll
        for (int i = 0; i < 16; ++i) acc[a][b][i] = 0.f;
    const u16* Ag = A + (size_t)(m0 + lrow) * K + lkc * 8;
    const u16* Bg = Bt + (size_t)(n0 + lrow) * K + lkc * 8;
    const size_t K32 = (size_t)32 * K;
    uint4 xa0, xa1, xa2, xa3, xb0, xb1, xb2, xb3;
    uint4 ya0, ya1, ya2, ya3, yb0, yb1, yb2, yb3;
#define G_LOAD(S, kt_) { const int ko_ = (kt_) * 64; \
      S##a0 = *(const uint4*)(Ag + ko_); S##a1 = *(const uint4*)(Ag + K32 + ko_); S##a2 = *(const uint4*)(Ag + 2 * K32 + ko_); S##a3 = *(const uint4*)(Ag + 3 * K32 + ko_); \
      S##b0 = *(const uint4*)(Bg + ko_); S##b1 = *(const uint4*)(Bg + K32 + ko_); S##b2 = *(const uint4*)(Bg + 2 * K32 + ko_); S##b3 = *(const uint4*)(Bg + 3 * K32 + ko_); }
#define G_STORE(S, st_) { u16* sa_ = sA + (st_) * (128 * 72) + lrow * 72 + lkc * 8; u16* sb_ = sB + (st_) * (128 * 72) + lrow * 72 + lkc * 8; \
      *(uint4*)(sa_) = S##a0; *(uint4*)(sa_ + 32 * 72) = S##a1; *(uint4*)(sa_ + 64 * 72) = S##a2; *(uint4*)(sa_ + 96 * 72) = S##a3; \
      *(uint4*)(sb_) = S##b0; *(uint4*)(sb_ + 32 * 72) = S##b1; *(uint4*)(sb_ + 64 * 72) = S##b2; *(uint4*)(sb_ + 96 * 72) = S##b3; }
#define G_COMPUTE(st_) { \
      const u16* a_ = sA + (st_) * (128 * 72) + (wm * 64 + r) * 72 + h * 8; \
      const u16* b_ = sB + (st_) * (128 * 72) + (wn * 64 + r) * 72 + h * 8; \
      __builtin_amdgcn_s_setprio(1); \
      _Pragma("unroll") for (int ks = 0; ks < 4; ++ks) { \
        bf16x8 a0 = *(const bf16x8*)(a_ + ks * 16), a1 = *(const bf16x8*)(a_ + 32 * 72 + ks * 16); \
        bf16x8 b0 = *(const bf16x8*)(b_ + ks * 16), b1 = *(const bf16x8*)(b_ + 32 * 72 + ks * 16); \
        acc[0][0] = MFMA32(a0, b0, acc[0][0]); acc[0][1] = MFMA32(a0, b1, acc[0][1]); \
        acc[1][0] = MFMA32(a1, b0, acc[1][0]); acc[1][1] = MFMA32(a1, b1, acc[1][1]); } \
      __builtin_amdgcn_s_setprio(0); }
    G_LOAD(x, 0);
    G_STORE(x, 0);
    __syncthreads();
    if (KT > 1) G_LOAD(x, 1);
    for (int kt = 0; kt < KT; kt += 2) {
      if (kt + 2 < KT && dummy != 2) G_LOAD(y, kt + 2);
      G_COMPUTE(0);
      if (kt + 1 < KT && dummy != 2) G_STORE(x, 1);
      __syncthreads();
      if (kt + 1 >= KT) break;
      if (kt + 3 < KT && dummy != 2) G_LOAD(x, kt + 3);
      G_COMPUTE(1);
      if (kt + 2 < KT && dummy != 2) G_STORE(y, 0);
      __syncthreads();
    }
#undef G_LOAD
#undef G_STORE
#undef G_COMPUTE
    int m0e = m0, n0e = n0;
    asm volatile("" : "+s"(m0e), "+s"(n0e));
    int rb = wm * 64 + 4 * h, cb = wn * 64 + r;
    asm volatile("" : "+v"(rb), "+v"(cb));
    if (EPI == EPI_P) {
      const int wc0 = n0e + (cb & 64);
      int vh = -1;
      if (wc0 >= 1344 && wc0 < 1472) vh = (wc0 - 1344) >> 6;
      else if (wc0 >= 1984 && wc0 < 2240) vh = 2 + ((wc0 - 1984) >> 6);
      else if (wc0 >= 2752 && wc0 < 3008) vh = 6 + ((wc0 - 2752) >> 6);
      if (vh >= 0) {
        const int bb = m0e / TALL, t0 = m0e - bb * TALL;
#pragma unroll
        for (int mi = 0; mi < 2; ++mi)
#pragma unroll
          for (int ni = 0; ni < 2; ++ni)
#pragma unroll
            for (int g4 = 0; g4 < 4; ++g4) {
              const int d = ni * 32 + (cb & 31);
              const int tkn = t0 + (rb & 64) + mi * 32 + 8 * g4 + (rb & 63);
              const int q4 = (tkn >> 2) & 3;
              const int tk = (tkn & ~15) | ((q4 == 1 ? 2 : (q4 == 2 ? 1 : q4)) << 2);
              uint2 w;
              w.x = pack2(acc[mi][ni][4 * g4], acc[mi][ni][4 * g4 + 1]);
              w.y = pack2(acc[mi][ni][4 * g4 + 2], acc[mi][ni][4 * g4 + 3]);
              *(uint2*)(P.vt + ((size_t)((bb * 10 + vh) * 64 + d)) * TALL + tk) = w;
            }
      } else
#pragma unroll
      for (int mi = 0; mi < 2; ++mi)
#pragma unroll
        for (int ni = 0; ni < 2; ++ni) {
          const int col = n0e + cb + ni * 32;
          if (col < INW && (dummy < 2 || acc[mi][ni][0] == 12345.678f)) {
            const bool odd = (cb & 1) != 0;
#pragma unroll
            for (int i = 0; i < 16; i += 2) {
              const float a = acc[mi][ni][i], b2 = acc[mi][ni][i + 1];
              const float recv = dpp_f(odd ? a : b2, 0);
              const int row = m0e + rb + mi * 32 + (i & 3) + 8 * (i >> 2) + (odd ? 1 : 0);
              const unsigned w = odd ? pack2(recv, b2) : pack2(a, recv);
              *(unsigned*)(P.pbuf + (size_t)row * INW + (col & ~1)) = w;
            }
          }
        }
    } else if (EPI == EPI_RES1 || EPI == EPI_RES2) {
      const int b = m0e / TALL, t0 = m0e - b * TALL;
      const bool isctx = t0 < CTX;
      float* xb = isctx ? P.zctx + ((size_t)(b * CTX + t0)) * D : P.out + ((size_t)(b * SEQ + t0 - CTX)) * D;
      const float* g = P.mod + ((size_t)(l * 17 + (isctx ? 16 : b))) * 6144 + (EPI == EPI_RES1 ? 2 * D : 5 * D);
      const float* xs = (EPI == EPI_RES1 && l == 0) ? (isctx ? P.ctx + ((size_t)(b * CTX + t0)) * D : P.x + ((size_t)(b * SEQ + t0 - CTX)) * D) : xb;
      const float gv0 = g[n0e + cb], gv1 = g[n0e + cb + 32];
      const bool haveln = !(EPI == EPI_RES1 && l == 0);
      const float* lgp = (EPI == EPI_RES1) ? P.post2_g + (size_t)(l > 0 ? l - 1 : 0) * D : P.post1_g + (size_t)l * D;
      const float* lbp = (EPI == EPI_RES1) ? P.post2_b + (size_t)(l > 0 ? l - 1 : 0) * D : P.post1_b + (size_t)l * D;
      const float lg0 = lgp[n0e + cb], lg1 = lgp[n0e + cb + 32], lb0 = lbp[n0e + cb], lb1 = lbp[n0e + cb + 32];
#pragma unroll
      for (int mi = 0; mi < 2; ++mi) {
        float xo[2][16];
        float2 ms[16];
#pragma unroll
        for (int ni = 0; ni < 2; ++ni)
#pragma unroll
          for (int i = 0; i < 16; ++i)
            xo[ni][i] = xs[(size_t)(rb + mi * 32 + (i & 3) + 8 * (i >> 2)) * D + n0e + cb + ni * 32];
#pragma unroll
        for (int i = 0; i < 16; ++i)
          ms[i] = haveln ? *(const float2*)(P.stats + (size_t)(m0e + rb + mi * 32 + (i & 3) + 8 * (i >> 2)) * 2) : make_float2(0.f, 1.f);
        if (haveln) {
#pragma unroll
          for (int ni = 0; ni < 2; ++ni)
#pragma unroll
            for (int i = 0; i < 16; ++i) xo[ni][i] = (xo[ni][i] - ms[i].x) * ms[i].y * (ni ? lg1 : lg0) + (ni ? lb1 : lb0);
        }
#pragma unroll
        for (int ni = 0; ni < 2; ++ni)
#pragma unroll
          for (int i = 0; i < 16; ++i) {
            float* px = xb + (size_t)(rb + mi * 32 + (i & 3) + 8 * (i >> 2)) * D + n0e + cb + ni * 32;
            if (dummy == 3) { if (acc[mi][ni][i] == 12345.678f) *px = 0.f; }
            else {
              float xn = ALPHA * xo[ni][i] + (ni ? gv1 : gv0) * acc[mi][ni][i];
              if (dummy) { asm volatile("" :: "v"(xn)); xn = xo[ni][i]; }
              *px = xn;
            }
          }
      }
    } else {
      const int hb = (n0e >> 7) * 64 + (cb >> 6) * 32 + (cb & 31);
      const bool odd = (cb & 1) != 0;
#pragma unroll
      for (int mi = 0; mi < 2; ++mi)
#pragma unroll
        for (int i = 0; i < 16; i += 2) {
          const float u0 = acc[mi][0][i], g0 = acc[mi][1][i], u1 = acc[mi][0][i + 1], g1 = acc[mi][1][i + 1];
          const float a = u0 * __builtin_amdgcn_rcpf(1.f + __expf(-u0)) * g0, b2 = u1 * __builtin_amdgcn_rcpf(1.f + __expf(-u1)) * g1;
          const float recv = dpp_f(odd ? a : b2, 0);
          const int row = m0e + rb + mi * 32 + (i & 3) + 8 * (i >> 2) + (odd ? 1 : 0);
          const unsigned w = odd ? pack2(recv, b2) : pack2(a, recv);
          *(unsigned*)(P.pbuf + (size_t)row * DFF + (hb & ~1)) = w;
        }
    }
  }
}

__device__ void phase_attnprep(const Params& P, int l, unsigned char* smem, int bid, int nb, const int dummy = 0) {
  const int tid = opaque_tid(), lane = tid & 63, wave = tid >> 6;
  for (int m = bid * 4 + wave; m < MALL; m += nb * 4) {
    const int b = m / TALL, t = m - b * TALL;
    const bool isctx = t < CTX;
    const int tp = t - CTX, rowp = tp >> 6, colp = tp & 63;
    u16* pr = P.pbuf + (size_t)m * INW;
    float xv[22];
#pragma unroll
    for (int ch = 0; ch < 22; ++ch) {
      const int col = ch < 4 ? 960 + ch * 64 : (ch < 6 ? 1216 + (ch - 4) * 64 : (ch < 10 ? 1472 + (ch - 6) * 64 : (ch < 14 ? 1728 + (ch - 10) * 64 : (ch < 18 ? 2240 + (ch - 14) * 64 : 2496 + (ch - 18) * 64))));
      xv[ch] = bf2f(pr[col + lane]);
    }
    float csA = 1.f, snA = 0.f, csD = 1.f, snD = 0.f, csR = 1.f, snR = 0.f;
    if (!isctx) {
      { const int e = lane & 31, pos = (lane >> 5) ? colp : rowp, i = e & 15; csA = P.ropeA[(pos * 16 + i) * 2]; snA = P.ropeA[(pos * 16 + i) * 2 + 1]; if (e < 16) snA = -snA; }
      { const int e = lane & 15, pos = ((lane >> 4) & 1) ? colp : rowp, i = e & 7; csD = P.ropeD[(pos * 8 + i) * 2]; snD = P.ropeD[(pos * 8 + i) * 2 + 1]; if (e < 8) snD = -snD; }
      { const int i = lane & 31; csR = P.ropeR[(tp * 32 + i) * 2]; snR = P.ropeR[(tp * 32 + i) * 2 + 1]; if (lane < 32) snR = -snR; }
    }
    const float gq = P.gqa_q_norm[l * 64 + lane], gk = P.gqa_k_norm[l * 64 + lane];
#pragma unroll
    for (int ch = 0; ch < 22; ++ch) {
      const int col = ch < 4 ? 960 + ch * 64 : (ch < 6 ? 1216 + (ch - 4) * 64 : (ch < 10 ? 1472 + (ch - 6) * 64 : (ch < 14 ? 1728 + (ch - 10) * 64 : (ch < 18 ? 2240 + (ch - 14) * 64 : 2496 + (ch - 18) * 64))));
      float x = xv[ch];
      if (ch < 6) {
        const float ss = wave_sum(x * x);
        x = x * rsqrtf(ss * (1.f / 64.f) + 1e-6f) * (ch < 4 ? gq : gk);
        const float partner = __shfl_xor(x, 16);
        x = x * csA + partner * snA;
        if (ch < 4) x *= 0.125f * LOG2E;
      } else if (ch < 14) {
        const float partner = __shfl_xor(x, 8);
        x = x * csD + partner * snD;
        if (ch < 10) x *= 0.17677669529663687f * LOG2E;
      } else {
        const float partner = __shfl_xor(x, 32);
        x = x * csR + partner * snR;
        if (ch >= 18) x *= 0.125f;
      }
      if (dummy) { asm volatile("" :: "v"(x)); x = xv[ch]; }
      pr[col + lane] = f2bf(x);
    }
  }
}

__device__ void scan_item(const Params& P, int l, int item, unsigned char* smem, const int pm = 0) {
  float* prep = (float*)smem;
  u16* raw = (u16*)(smem + 49152);
  u16* twb = (u16*)(smem + 49152 + 17408);
  u16* tab = twb + 32 * 40;
  float* ybuf = (float*)(smem + 49152 + 17408 + 8192);
  const int tid = opaque_tid(), lane = tid & 63, wave = tid >> 6;
  __builtin_amdgcn_s_setprio(3);
  const int dir = item >> 7, b = (item >> 3) & 15, hh = (item >> 1) & 3, hf = item & 1;
  const int c = tid;
  int pcol;
  if (c < 64) pcol = hh * 64 + c; else if (c < 128) pcol = 256 + hh * 64 + (c - 64); else if (c < 192) pcol = 512 + hh * 64 + (c - 128);
  else if (c < 224) pcol = 768 + dir * 32 + (c - 192); else pcol = 832 + dir * 32 + (c - 224);
  const float mu = P.rwkv_mu[l * 960 + pcol];
  const int kB = tid & 63, tg = tid >> 6;
  const int wv = __builtin_amdgcn_readfirstlane(wave);
  bf16x8 bfr0, bfr1;
  {
    const float* up = ((wv >> 1) ? P.rwkv_a_up : P.rwkv_w_up) + ((size_t)((l * 2 + dir) * 32)) * 256 + hh * 64 + (wv & 1) * 32 + (lane & 31);
    const int hq = lane >> 5;
    u32x4 t0, t1;
#pragma unroll
    for (int jj = 0; jj < 4; ++jj) {
      t0[jj] = pack2(up[(size_t)(8 * hq + 2 * jj) * 256], up[(size_t)(8 * hq + 2 * jj + 1) * 256]);
      t1[jj] = pack2(up[(size_t)(16 + 8 * hq + 2 * jj) * 256], up[(size_t)(16 + 8 * hq + 2 * jj + 1) * 256]);
    }
    bfr0 = __builtin_bit_cast(bf16x8, t0); bfr1 = __builtin_bit_cast(bf16x8, t1);
  }
  const float w0 = P.rwkv_w0[(l * 2 + dir) * 256 + hh * 64 + kB], a0 = P.rwkv_a0[(l * 2 + dir) * 256 + hh * 64 + kB];
  const float ka = P.rwkv_k_a[l * 256 + hh * 64 + kB], rk = P.rwkv_r_k[(l * 4 + hh) * 64 + kB];
  const float kkwB = P.rwkv_k_k[l * 256 + hh * 64 + kB];
  const int vec = tid & 31;
  int vcol;
  if (vec < 8) vcol = hh * 64 + vec * 8; else if (vec < 16) vcol = 256 + hh * 64 + (vec - 8) * 8; else if (vec < 24) vcol = 512 + hh * 64 + (vec - 16) * 8;
  else if (vec < 28) vcol = 768 + dir * 32 + (vec - 24) * 8; else vcol = 832 + dir * 32 + (vec - 28) * 8;
  const u16* pb = P.pbuf + (size_t)(b * TALL) * INW + vcol;
  f32v2 S0 = {0.f, 0.f}, S1 = S0, S2 = S0, S3 = S0;
  const int rowl = wave * 8 + (lane >> 3), ks = lane & 7;
  uint4 rg0 = make_uint4(0, 0, 0, 0), rg1 = rg0, rg2 = rg0, rg3 = rg0, rg4 = rg0;

  for (int ch = -1; ch < 72; ++ch) {
    const int nx = ch + 1;
    const bool more = nx < 72;
    if (more) {
      const int n0 = nx * 32; const bool cx = n0 < 256;
      const int tlo = dir ? (cx ? 224 - n0 : 2528 - n0) : n0;
      const int slo = cx ? 0 : 256, shi = cx ? 256 : 2304;
      rg0 = *(const uint4*)(pb + (size_t)(tlo + (tid >> 5)) * INW);
      rg1 = *(const uint4*)(pb + (size_t)(tlo + (tid >> 5) + 8) * INW);
      rg2 = *(const uint4*)(pb + (size_t)(tlo + (tid >> 5) + 16) * INW);
      rg3 = *(const uint4*)(pb + (size_t)(tlo + (tid >> 5) + 24) * INW);
      rg4 = make_uint4(0, 0, 0, 0);
      if (tid < 64) { const int tok = (tid >> 5) ? tlo + 32 : tlo - 1; if (tok >= slo && tok < shi) rg4 = *(const uint4*)(pb + (size_t)tok * INW); }
    }
    if (ch >= 0 && !(pm & 1)) {
      {
        const float* psb = prep + ks * 8;
        const float* pvb = prep + 320 + hf * 32 + rowl;
        float4 nap0 = *(const float4*)(psb), nap1 = *(const float4*)(psb + 4);
        float4 nw0 = *(const float4*)(psb + 64), nw1 = *(const float4*)(psb + 68);
        float4 nbp0 = *(const float4*)(psb + 128), nbp1 = *(const float4*)(psb + 132);
        float4 nkd0 = *(const float4*)(psb + 192), nkd1 = *(const float4*)(psb + 196);
        float4 nr0 = *(const float4*)(psb + 256), nr1 = *(const float4*)(psb + 260);
        float nvv = pvb[0];
#pragma unroll 2
        for (int step = 0; step < 32; ++step) {
          const float4 ap0 = nap0, ap1 = nap1, w0v = nw0, w1v = nw1, bp0 = nbp0, bp1 = nbp1, kd0 = nkd0, kd1 = nkd1, r0 = nr0, r1 = nr1;
          const float vv = nvv;
          {
            const int nxs = (step < 31) ? step + 1 : 31;
            const float* ps = psb + nxs * 384;
            nap0 = *(const float4*)(ps); nap1 = *(const float4*)(ps + 4);
            nw0 = *(const float4*)(ps + 64); nw1 = *(const float4*)(ps + 68);
            nbp0 = *(const float4*)(ps + 128); nbp1 = *(const float4*)(ps + 132);
            nkd0 = *(const float4*)(ps + 192); nkd1 = *(const float4*)(ps + 196);
            nr0 = *(const float4*)(ps + 256); nr1 = *(const float4*)(ps + 260);
            nvv = pvb[nxs * 384];
          }
          f32v2 t = S0 * (f32v2){ap0.x, ap0.y};
          t = S1 * (f32v2){ap0.z, ap0.w} + t;
          t = S2 * (f32v2){ap1.x, ap1.y} + t;
          t = S3 * (f32v2){ap1.z, ap1.w} + t;
          const float sa = reduce8(t.x + t.y);
          const f32v2 sa2 = {sa, sa}, vv2 = {vv, vv};
          S0 = S0 * (f32v2){w0v.x, w0v.y} + (sa2 * (f32v2){bp0.x, bp0.y} + vv2 * (f32v2){kd0.x, kd0.y});
          S1 = S1 * (f32v2){w0v.z, w0v.w} + (sa2 * (f32v2){bp0.z, bp0.w} + vv2 * (f32v2){kd0.z, kd0.w});
          S2 = S2 * (f32v2){w1v.x, w1v.y} + (sa2 * (f32v2){bp1.x, bp1.y} + vv2 * (f32v2){kd1.x, kd1.y});
          S3 = S3 * (f32v2){w1v.z, w1v.w} + (sa2 * (f32v2){bp1.z, bp1.w} + vv2 * (f32v2){kd1.z, kd1.w});
          f32v2 u = S0 * (f32v2){r0.x, r0.y};
          u = S1 * (f32v2){r0.z, r0.w} + u;
          u = S2 * (f32v2){r1.x, r1.y} + u;
          u = S3 * (f32v2){r1.z, r1.w} + u;
          const float y = reduce8(u.x + u.y);
          if (ks == 0) ybuf[step * 32 + rowl] = y;
        }
      }
      __syncthreads();
      {
        const int step = tid >> 3, q = tid & 7;
        const int n = ch * 32 + step;
        const int tok = dir ? (n < 256 ? 255 - n : 2559 - n) : n;
        float4 yv = *(const float4*)(ybuf + step * 32 + q * 4);
        if (!(pm & 8)) { uint2 w; w.x = pack2(yv.x, yv.y); w.y = pack2(yv.z, yv.w); *(uint2*)(P.yd + ((size_t)(dir * MALL + b * TALL + tok)) * 256 + hh * 64 + hf * 32 + q * 4) = w; }
      }
    }
    if (more) {
      *(uint4*)(raw + (1 + (tid >> 5)) * 256 + vec * 8) = rg0;
      *(uint4*)(raw + (9 + (tid >> 5)) * 256 + vec * 8) = rg1;
      *(uint4*)(raw + (17 + (tid >> 5)) * 256 + vec * 8) = rg2;
      *(uint4*)(raw + (25 + (tid >> 5)) * 256 + vec * 8) = rg3;
      if (tid < 64) *(uint4*)(raw + ((tid >> 5) ? 33 : 0) * 256 + vec * 8) = rg4;
      __syncthreads();
      if (!(pm & 2)) {
        float pv[34];
#pragma unroll
        for (int j = 0; j < 34; ++j) pv[j] = bf2f(raw[j * 256 + c]);
        if (wv < 3) {
          float* pdst = prep + (wv == 0 ? 256 + c : (wv == 1 ? 192 + (c - 64) : 320 + (c - 128)));
#pragma unroll
          for (int j = 0; j < 32; ++j) {
            const float psv = pv[j + 1] + mu * (0.5f * (pv[j] + pv[j + 2]) - pv[j + 1]);
            pdst[(dir ? 31 - j : j) * 384] = psv;
          }
        } else {
          u16* tdst = ((c < 224) ? twb : tab) + ((c - 192) & 31);
#pragma unroll
          for (int j = 0; j < 32; ++j) {
            const float psv = pv[j + 1] + mu * (0.5f * (pv[j] + pv[j + 2]) - pv[j + 1]);
            const float th = 1.f - 2.f * __builtin_amdgcn_rcpf(__expf(2.f * psv) + 1.f);
            tdst[(dir ? 31 - j : j) * 40] = f2bf((c < 224) ? th : psv);
          }
        }
      }
      __syncthreads();
      if (!(pm & 4)) {
        const int r = lane & 31, hq = lane >> 5;
        const u16* asrc = ((wv >> 1) ? tab : twb) + r * 40 + 8 * hq;
        const bf16x8 af0 = *(const bf16x8*)(asrc), af1 = *(const bf16x8*)(asrc + 16);
        f32x16 accl;
#pragma unroll
        for (int i = 0; i < 16; ++i) accl[i] = 0.f;
        accl = MFMA32(af0, bfr0, accl);
        accl = MFMA32(af1, bfr1, accl);
        float* odst = prep + ((wv >> 1) ? 128 : 64) + (wv & 1) * 32 + r;
#pragma unroll
        for (int i = 0; i < 16; ++i) odst[crow(i, hq) * 384] = accl[i];
      }
      __syncthreads();
      if (!(pm & 4)) {
        const int n0 = nx * 32;
#pragma unroll 2
        for (int s = 0; s < 8; ++s) {
          const int step = tg * 8 + s;
          float* pp = prep + step * 384;
          const float wacc = w0 + pp[64 + kB], aacc = a0 + pp[128 + kB];
          const float sg = __builtin_amdgcn_rcpf(1.f + __expf(-wacc));
          const float decay = __expf(-0.6065306597126334f * sg);
          const float av = __builtin_amdgcn_rcpf(1.f + __expf(-aacc));
          const float ksv = pp[192 + kB];
          const float xk = ksv * kkwB;
          const float kk = xk * rsqrtf(fmaxf(wave_sum(xk * xk), 1e-24f));
          const float kd = ksv * (1.f + (av - 1.f) * ka);
          pp[64 + kB] = decay; pp[192 + kB] = kd; pp[128 + kB] = kk * av; pp[kB] = -kk;
          const float cs = wave_sum(pp[256 + kB] * kd * rk);
          if (lane == 0 && hf == 0 && !(pm & 8)) {
            const int n = n0 + step;
            const int tok = dir ? (n < 256 ? 255 - n : 2559 - n) : n;
            P.cbuf[((size_t)(dir * MALL + b * TALL + tok)) * 4 + hh] = cs;
          }
        }
      }
    }
    __syncthreads();
  }
  __builtin_amdgcn_s_setprio(0);
}

template <int KIND>
__device__ void attn_item(const Params& P, int l, int b, int hh, int qb, bool isctx, unsigned char* smem) {
  constexpr int NMAP = (KIND == 1) ? 2 : 1;
  constexpr int NKS = (KIND == 1) ? 2 : 4;
  u16* sK = (u16*)smem;
  u16* sV = sK + 2 * 64 * 72;
  float* stash = (float*)(smem + 4 * 64 * 72 * 2);
  const int tid = opaque_tid(), lane = tid & 63, wave = tid >> 6, r = lane & 31, h = lane >> 5;
  int qcol, kcol, vh, ycol;
  if (KIND == 0) { qcol = 960 + hh * 64; kcol = 1216 + (hh >> 1) * 64; vh = hh >> 1; ycol = 256 + hh * 64; }
  else if (KIND == 1) { qcol = 1472 + hh * 64; kcol = 1728 + hh * 64; vh = 2 + hh; ycol = 512 + hh * 64; }
  else { qcol = 2240 + hh * 64; kcol = 2496 + hh * 64; vh = 6 + hh; ycol = 768 + hh * 64; }
  const int iq = qb * 128 + wave * 32 + r;
  const int tq = b * TALL + (isctx ? 0 : CTX) + iq;
  const int ntiles = isctx ? 4 : 36;
  float lgf = 0.f, lgb = 0.f;
  if (KIND == 2) { lgf = log2f(1.f - exp2f(-5.f - (float)hh)); lgb = log2f(1.f - exp2f(-5.f - (float)(3 - hh))); }
  float cf[16], cb[16], ckf = 1.f, ckb = 1.f;
  if (KIND == 2) {
#pragma unroll
    for (int i = 0; i < 16; ++i) {
      const float o_ = (float)crow(i, h);
      cf[i] = __builtin_amdgcn_exp2f(-o_ * lgf);
      cb[i] = __builtin_amdgcn_exp2f(o_ * lgb);
    }
    ckf = __builtin_amdgcn_exp2f(-32.f * lgf); ckb = __builtin_amdgcn_exp2f(32.f * lgb);
  }
  const int q0w = qb * 128 + wave * 32;
  const int lrow = tid >> 3, lvec = tid & 7;
  const u16* Kg = P.pbuf + (size_t)(b * TALL + lrow) * INW + kcol + lvec * 8;
  const u16* Vg = P.vt + ((size_t)((b * 10 + vh) * 64 + lrow)) * TALL + lvec * 8;
  float o[2][16];
  {
    bf16x8 qf[NMAP][NKS];
    f32x16 O[NMAP][2];
    float mrun[NMAP], lsum[NMAP];
#pragma unroll
    for (int mp = 0; mp < NMAP; ++mp) {
      mrun[mp] = 0.f; lsum[mp] = 0.f;
#pragma unroll
      for (int ks = 0; ks < NKS; ++ks) qf[mp][ks] = *(const bf16x8*)(P.pbuf + (size_t)tq * INW + qcol + mp * 32 + ks * 16 + h * 8);
#pragma unroll
      for (int dt = 0; dt < 2; ++dt)
#pragma unroll
        for (int i = 0; i < 16; ++i) O[mp][dt][i] = 0.f;
    }
    uint4 xk0, xk1, xv0, xv1;
#define ATT_LOAD(S, t_) { S##k0 = *(const uint4*)(Kg + (size_t)((t_) * 64) * INW); S##k1 = *(const uint4*)(Kg + (size_t)((t_) * 64 + 32) * INW); \
      S##v0 = *(const uint4*)(Vg + (t_) * 64); S##v1 = *(const uint4*)(Vg + (size_t)32 * TALL + (t_) * 64); }
#define ATT_STORE(S, st_) { u16* k2 = sK + (st_) * (64 * 72); u16* v2 = sV + (st_) * (64 * 72); \
      *(uint4*)(k2 + lrow * 72 + lvec * 8) = S##k0; *(uint4*)(k2 + (lrow + 32) * 72 + lvec * 8) = S##k1; \
      *(uint4*)(v2 + lrow * 72 + lvec * 8) = S##v0; *(uint4*)(v2 + (lrow + 32) * 72 + lvec * 8) = S##v1; }
#define ATT_COMPUTE(t_, st_) { \
      const int t = (t_); \
      const u16* k_ = sK + (st_) * (64 * 72); \
      const u16* v_ = sV + (st_) * (64 * 72); \
      _Pragma("unroll") for (int mp = 0; mp < NMAP; ++mp) { \
      f32x16 st[2]; \
      const float sinit = (KIND != 2 && t > 0) ? -mrun[mp] : 0.f;     \
      _Pragma("unroll") for (int kt = 0; kt < 2; ++kt) { \
        _Pragma("unroll") for (int i = 0; i < 16; ++i) st[kt][i] = sinit; \
        _Pragma("unroll") for (int ks = 0; ks < NKS; ++ks) { \
          bf16x8 kf = *(const bf16x8*)(k_ + (kt * 32 + r) * 72 + mp * 32 + ks * 16 + h * 8); \
          st[kt] = MFMA32(kf, qf[mp][ks], st[kt]); \
        } \
      } \
      int rmode = 0; float rff = 0.f, rbb = 0.f; \
      if (KIND == 2) { \
        const int kb = t * 64 - (isctx ? 0 : 256); \
        if (!isctx && t < 4) { rmode = 3; rff = __builtin_amdgcn_exp2f((float)(iq - kb) * lgf); rbb = __builtin_amdgcn_exp2f((float)(2048 - iq + t * 64) * lgb); } \
        else if (kb + 63 < q0w) { rmode = 1; rff = __builtin_amdgcn_exp2f((float)(iq - kb) * lgf); } \
        else if (kb > q0w + 31) { rmode = 2; rbb = __builtin_amdgcn_exp2f((float)(kb - iq) * lgb); } \
      } \
      if (KIND != 2) { \
        float mx = st[0][0]; \
        _Pragma("unroll") for (int kt = 0; kt < 2; ++kt) \
          _Pragma("unroll") for (int i = 0; i < 16; ++i) mx = fmaxf(mx, st[kt][i]); \
        mx = xhalf_max(mx); \
        if (t == 0) {                        \
          mrun[mp] = mx; \
          _Pragma("unroll") for (int kt = 0; kt < 2; ++kt) \
            _Pragma("unroll") for (int i = 0; i < 16; ++i) st[kt][i] -= mx; \
        } else if (__builtin_amdgcn_ballot_w64(mx > 8.f) != 0ull) {     \
          const float delta = fmaxf(mx, 0.f); \
          const float alpha = __builtin_amdgcn_exp2f(-delta); \
          mrun[mp] += delta; \
          lsum[mp] *= alpha; \
          _Pragma("unroll") for (int kt = 0; kt < 2; ++kt) \
            _Pragma("unroll") for (int i = 0; i < 16; ++i) st[kt][i] -= delta; \
          _Pragma("unroll") for (int dt = 0; dt < 2; ++dt) \
            _Pragma("unroll") for (int i = 0; i < 16; ++i) O[mp][dt][i] *= alpha; \
        } \
      } \
      _Pragma("unroll") for (int kt = 0; kt < 2; ++kt) { \
        if (KIND != 2) { \
          f32v2 ps2 = {0.f, 0.f}; \
          _Pragma("unroll") for (int i = 0; i < 16; i += 2) { \
            const float p0 = __builtin_amdgcn_exp2f(st[kt][i]), p1 = __builtin_amdgcn_exp2f(st[kt][i + 1]); \
            st[kt][i] = p0; st[kt][i + 1] = p1; ps2 += (f32v2){p0, p1}; } \
          lsum[mp] += ps2.x + ps2.y; \
        } else if (rmode != 0) { \
          const float rf_ = kt ? rff * ckf : rff, rb_ = kt ? rbb * ckb : rbb; \
          _Pragma("unroll") for (int i = 0; i < 16; ++i) st[kt][i] *= rf_ * cf[i] + rb_ * cb[i]; \
        } else { \
          const int kbase = t * 64 - (isctx ? 0 : 256); \
          _Pragma("unroll") for (int i = 0; i < 16; ++i) { \
            const int df = iq - (kbase + kt * 32 + crow(i, h)); \
            const float e = __builtin_amdgcn_exp2f(df > 0 ? (float)df * lgf : (float)(-df) * lgb); \
            st[kt][i] *= (df == 0) ? 2.f : e; \
          } \
        } \
        _Pragma("unroll") for (int s = 0; s < 2; ++s) { \
          u32x4 pbu; \
          pbu[0] = pack2(st[kt][8 * s + 0], st[kt][8 * s + 1]); pbu[1] = pack2(st[kt][8 * s + 2], st[kt][8 * s + 3]); \
          pbu[2] = pack2(st[kt][8 * s + 4], st[kt][8 * s + 5]); pbu[3] = pack2(st[kt][8 * s + 6], st[kt][8 * s + 7]); \
          const bf16x8 pbv = __builtin_bit_cast(bf16x8, pbu); \
          _Pragma("unroll") for (int dt = 0; dt < 2; ++dt) { \
            const bf16x8 vfv = *(const bf16x8*)(v_ + (dt * 32 + r) * 72 + kt * 32 + s * 16 + 8 * h);     \
            O[mp][dt] = MFMA32(vfv, pbv, O[mp][dt]); \
          } \
        } \
      } \
      } }
    ATT_LOAD(x, 0);
    ATT_STORE(x, 0);
    __syncthreads();
    for (int tt = 0; tt < ntiles; ++tt) {
      const int cur = tt & 1;
      if (tt + 1 < ntiles) ATT_LOAD(x, tt + 1);
      ATT_COMPUTE(tt, cur);
      if (tt + 1 < ntiles) ATT_STORE(x, cur ^ 1);
      __syncthreads();
    }
#undef ATT_LOAD
#undef ATT_STORE
#undef ATT_COMPUTE
    if (KIND == 0) {
      const float inv = 1.f / (lsum[0] + __shfl_xor(lsum[0], 32));
#pragma unroll
      for (int dt = 0; dt < 2; ++dt)
#pragma unroll
        for (int i = 0; i < 16; ++i) o[dt][i] = O[0][dt][i] * inv;
    } else if (KIND == 1) {
      const float inv0 = 1.f / (lsum[0] + __shfl_xor(lsum[0], 32));
      const float inv1 = P.lamv[l * 2] / (lsum[NMAP - 1] + __shfl_xor(lsum[NMAP - 1], 32));
#pragma unroll
      for (int dt = 0; dt < 2; ++dt)
#pragma unroll
        for (int i = 0; i < 16; ++i) o[dt][i] = O[0][dt][i] * inv0 - O[NMAP - 1][dt][i] * inv1;
    } else {
#pragma unroll
      for (int dt = 0; dt < 2; ++dt)
#pragma unroll
        for (int i = 0; i < 16; ++i) o[dt][i] = O[0][dt][i];
    }
  }
  if (KIND == 1) {
    float ss = 0.f;
#pragma unroll
    for (int dt = 0; dt < 2; ++dt)
#pragma unroll
      for (int i = 0; i < 16; ++i) ss += o[dt][i] * o[dt][i];
    ss += __shfl_xor(ss, 32);
    const float sc = rsqrtf(ss * (1.f / 64.f) + 1e-6f) * (1.f - P.lamv[l * 2 + 1]);
#pragma unroll
    for (int dt = 0; dt < 2; ++dt)
#pragma unroll
      for (int i = 0; i < 16; ++i) o[dt][i] *= sc * P.diff_norm[l * 64 + dt * 32 + crow(i, h)];
  } else if (KIND == 2) {
    float s = 0.f;
#pragma unroll
    for (int dt = 0; dt < 2; ++dt)
#pragma unroll
      for (int i = 0; i < 16; ++i) s += o[dt][i];
    s += __shfl_xor(s, 32);
    const float mean = s * (1.f / 64.f);
    float q = 0.f;
#pragma unroll
    for (int dt = 0; dt < 2; ++dt)
#pragma unroll
      for (int i = 0; i < 16; ++i) { const float x = o[dt][i] - mean; o[dt][i] = x; q += x * x; }
    q += __shfl_xor(q, 32);
    const float rstd = rsqrtf(q * (1.f / 64.f) + 1e-5f);
#pragma unroll
    for (int dt = 0; dt < 2; ++dt)
#pragma unroll
      for (int g = 0; g < 4; ++g) {
        const int d0 = dt * 32 + 8 * g + 4 * h;
        const uint2 gt = *(const uint2*)(P.pbuf + (size_t)tq * INW + 3008 + hh * 64 + d0);
        const float g0 = bf2f((u16)(gt.x & 0xffff)), g1 = bf2f((u16)(gt.x >> 16)), g2 = bf2f((u16)(gt.y & 0xffff)), g3 = bf2f((u16)(gt.y >> 16));
        o[dt][4 * g + 0] *= rstd * g0 / (1.f + __expf(-g0));
        o[dt][4 * g + 1] *= rstd * g1 / (1.f + __expf(-g1));
        o[dt][4 * g + 2] *= rstd * g2 / (1.f + __expf(-g2));
        o[dt][4 * g + 3] *= rstd * g3 / (1.f + __expf(-g3));
      }
  }
#pragma unroll
  for (int dt = 0; dt < 2; ++dt)
#pragma unroll
    for (int gp = 0; gp < 4; gp += 2) {
      unsigned ax = pack2(o[dt][4 * gp], o[dt][4 * gp + 1]), ay = pack2(o[dt][4 * gp + 2], o[dt][4 * gp + 3]);
      unsigned bx = pack2(o[dt][4 * gp + 4], o[dt][4 * gp + 5]), by = pack2(o[dt][4 * gp + 6], o[dt][4 * gp + 7]);
      const auto rx = __builtin_amdgcn_permlane32_swap(ax, bx, false, false);
      const auto ry = __builtin_amdgcn_permlane32_swap(ay, by, false, false);
      ax = rx[0]; bx = rx[1]; ay = ry[0]; by = ry[1];
      *(uint4*)(P.abuf + (size_t)tq * D + ycol + dt * 32 + 8 * gp + 8 * h) = make_uint4(ax, ay, bx, by);
    }
}

__device__ void phase_mixers(const Params& P, int l, unsigned char* smem, int cbase = 0, int mode = 0) {
  __shared__ int s_item;
  const int natt = (mode == 1 || mode == 3) ? 0 : 3072 + (l < NL - 1 ? 384 : 0);
  unsigned* qatt = P.counters + cbase + l;
  unsigned* qscan = P.counters + cbase + 16 + l;
  if (threadIdx.x == 0) {
    const unsigned key = xb_xcc_id() * 256u + ((unsigned)__builtin_amdgcn_s_getreg((6 << 11) | (8 << 6) | 4) & 0x7Fu);
    const unsigned slot = atomicAdd(P.cucnt + key, 1u);
    int it = -1;
    if ((slot & 1u) == 0u && mode != 2) { it = (int)atomicAdd(qscan, 1u); if (it >= 256) it = -1; }
    s_item = it;
  }
  __syncthreads();
  {
    const int it = s_item;
    __syncthreads();
    if (it >= 0) scan_item(P, l, it, smem, (mode == 3) ? (8 | SCAN_PM) : 0);
  }
  for (;;) {
    if (threadIdx.x == 0) s_item = (int)atomicAdd(qatt, 1u);
    __syncthreads();
    const int item = s_item;
    __syncthreads();
    if (item >= natt) break;
    int idx = item;
    int kind, b, hh, qb; bool isctx;
    if (idx < 3072) { kind = idx >> 10; kind = (kind == 0) ? 1 : (kind == 1 ? 0 : 2); int rem = idx & 1023; b = rem >> 6; hh = (rem >> 4) & 3; qb = rem & 15; isctx = false; }
    else { idx -= 3072; kind = idx >> 7; int rem = idx & 127; b = rem >> 3; hh = (rem >> 1) & 3; qb = rem & 1; isctx = true; }
    if (kind == 0) attn_item<0>(P, l, b, hh, qb, isctx, smem);
    else if (kind == 1) attn_item<1>(P, l, b, hh, qb, isctx, smem);
    else attn_item<2>(P, l, b, hh, qb, isctx, smem);
  }
  for (;;) {
    if (threadIdx.x == 0) s_item = (int)atomicAdd(qscan, 1u);
    __syncthreads();
    const int item = s_item;
    __syncthreads();
    if (item >= 256 || mode == 2 || mode == 3) break;
    scan_item(P, l, item, smem);
  }
}

__device__ void phase_rwkv_combine(const Params& P, int l, unsigned char* smem, int bid, int nb) {
  float* sg = (float*)smem;
  const int tid = opaque_tid(), wave = tid >> 6, c = tid;
  float gup[64];
#pragma unroll
  for (int r = 0; r < 64; ++r) gup[r] = P.rwkv_g_up[((size_t)(l * 64 + r)) * 256 + c];
  const float lng = P.rwkv_ln_g[l * 256 + c], lnb = P.rwkv_ln_b[l * 256 + c], mu_v = P.rwkv_mu[l * 960 + 512 + c];
  const float mu_g = P.rwkv_mu[l * 960 + 896 + (tid & 63)];
  const bool latent_only = (l == NL - 1);
  for (int tile = bid; tile < MALL / 16; tile += nb) {
    const int m0 = tile * 16, b = m0 / TALL, t0 = m0 - b * TALL;
    const bool isctx = t0 < CTX;
    if (latent_only && isctx) continue;
    const int seglo = b * TALL + (isctx ? 0 : CTX), seghi = b * TALL + (isctx ? CTX : TALL);
#pragma unroll
    for (int i = 0; i < 4; ++i) {
      const int idx = tid + 256 * i, tok = idx >> 6, r = idx & 63;
      const int m = m0 + tok;
      const u16* pp = P.pbuf + (size_t)m * INW + 896 + r;
      const float pc = bf2f(pp[0]);
      const float pm = (m - 1 >= seglo) ? bf2f(*(pp - INW)) : 0.f;
      const float pn = (m + 1 < seghi) ? bf2f(*(pp + INW)) : 0.f;
      const float ps = pc + mu_g * (0.5f * (pm + pn) - pc);
      sg[tok * 64 + r] = 1.f / (1.f + expf(-ps));
    }
    __syncthreads();
#pragma unroll 1
    for (int tq4 = 0; tq4 < 16; tq4 += 4) {
      float ya[4], yb[4], pcv[4], pmv[4], pnv[4], csa[4], csb[4];
#pragma unroll
      for (int u = 0; u < 4; ++u) {
        const int m = m0 + tq4 + u;
        ya[u] = bf2f(P.yd[((size_t)m) * 256 + c]); yb[u] = bf2f(P.yd[((size_t)(MALL + m)) * 256 + c]);
        const u16* pv = P.pbuf + (size_t)m * INW + 512 + c;
        pcv[u] = bf2f(pv[0]);
        pmv[u] = (m - 1 >= seglo) ? bf2f(*(pv - INW)) : 0.f;
        pnv[u] = (m + 1 < seghi) ? bf2f(*(pv + INW)) : 0.f;
        csa[u] = P.cbuf[((size_t)m) * 4 + wave]; csb[u] = P.cbuf[((size_t)(MALL + m)) * 4 + wave];
      }
#pragma unroll
      for (int u = 0; u < 4; ++u) {
        const int tok = tq4 + u, m = m0 + tok;
        float gacc = 0.f;
#pragma unroll
        for (int r = 0; r < 64; r += 4) {
          const float4 s4 = *(const float4*)(sg + tok * 64 + r);
          gacc += s4.x * gup[r] + s4.y * gup[r + 1] + s4.z * gup[r + 2] + s4.w * gup[r + 3];
        }
        const float y = ya[u] + yb[u];
        const float mean = wave_sum(y) * (1.f / 64.f);
        const float dd = y - mean;
        const float var = wave_sum(dd * dd) * (1.f / 64.f);
        const float yn = dd * rsqrtf(var + 64e-5f) * lng + lnb;
        const float vs = pcv[u] + mu_v * (0.5f * (pmv[u] + pnv[u]) - pcv[u]);
        P.abuf[(size_t)m * D + c] = f2bf((yn + (csa[u] + csb[u]) * vs) * gacc);
      }
    }
    __syncthreads();
  }
}

__device__ void run_phase(const Params& P, int ph, unsigned char* smem, int bid, int nb, const XcdBarrier* xbp) {
  if (ph == 1 + 9 * NL) { phase_prep(P, NL - 1, 2, bid, nb); return; }
  const int l = (ph - 1) / 9, s = (ph - 1) - l * 9;
  const bool last = (l == NL - 1);
  switch (s) {
    case 0:
      phase_prep(P, l, 0, bid, nb);
      for (int t = bid; t < NWCONV; t += nb) wconv_tile(P, l, t, smem);
      break;
    case 1:
      phase_gemm<EPI_P, false>(P, l, P.abuf, P.w_in_t, D, INWP / 128, smem, bid, nb);
#if PROBE == 1 || PROBE == 13
      phase_gemm<EPI_P, false>(P, l, P.abuf, P.w_in_t, D, INWP / 128, smem, bid, nb);
#elif PROBE == 14
      phase_gemm<EPI_P, false>(P, l, P.abuf, P.w_in_t, D, INWP / 128, smem, bid, nb, 2);
#elif PROBE == 15
      phase_gemm<EPI_P, false>(P, l, P.abuf, P.w_in_t, D, INWP / 128, smem, bid, nb, 3);
#endif
      break;
    case 2:
      phase_attnprep(P, l, smem, bid, nb);
#if PROBE == 9
      phase_attnprep(P, l, smem, bid, nb, 1);
#endif
      break;
    case 3:
      phase_mixers(P, l, smem);
#if PROBE == 6
      xcd_barrier(*xbp);
      phase_mixers(P, l, smem, 32);
#elif PROBE == 2
      xcd_barrier(*xbp);
      phase_mixers(P, l, smem, 32, 1);
#elif PROBE == 3
      xcd_barrier(*xbp);
      phase_mixers(P, l, smem, 32, 2);
#elif PROBE == 8
      xcd_barrier(*xbp);
      phase_mixers(P, l, smem, 32, 3);
#endif
      break;
    case 4:
      phase_rwkv_combine(P, l, smem, bid, nb);
#if PROBE == 5
      phase_rwkv_combine(P, l, smem, bid, nb);
#endif
      break;
    case 5:
      if (last) phase_gemm<EPI_RES1, true>(P, l, P.abuf, P.w_out_t, D, D / 128, smem, bid, nb);
      else phase_gemm<EPI_RES1, false>(P, l, P.abuf, P.w_out_t, D, D / 128, smem, bid, nb);
#if PROBE == 11
      phase_gemm<EPI_RES1, false>(P, l, P.abuf, P.w_out_t, D, D / 128, smem, bid, nb, 1);
#endif
      break;
    case 6:
      phase_prep(P, l, 1, bid, nb);
#if PROBE == 10
      phase_prep(P, l, 1, bid, nb, 1);
#endif
      break;
    case 7:
      if (last) phase_gemm<EPI_SWIGLU, true>(P, l, P.abuf, P.ffn_in_t, D, (2 * DFF) / 128, smem, bid, nb);
      else phase_gemm<EPI_SWIGLU, false>(P, l, P.abuf, P.ffn_in_t, D, (2 * DFF) / 128, smem, bid, nb);
#if PROBE == 1
      phase_gemm<EPI_SWIGLU, false>(P, l, P.abuf, P.ffn_in_t, D, (2 * DFF) / 128, smem, bid, nb);
#endif
      break;
    case 8:
      if (last) phase_gemm<EPI_RES2, true>(P, l, P.pbuf, P.ffn_out_t, DFF, D / 128, smem, bid, nb);
      else phase_gemm<EPI_RES2, false>(P, l, P.pbuf, P.ffn_out_t, DFF, D / 128, smem, bid, nb);
#if PROBE == 12
      phase_gemm<EPI_RES2, false>(P, l, P.pbuf, P.ffn_out_t, DFF, D / 128, smem, bid, nb, 1);
#elif PROBE == 16
      phase_gemm<EPI_RES2, false>(P, l, P.pbuf, P.ffn_out_t, DFF, D / 128, smem, bid, nb, 3);
#endif
      break;
  }
}

__global__ void __launch_bounds__(256, 2) fwd_megakernel(Params P, int ph_begin, int ph_end) {
  __shared__ __attribute__((aligned(16))) unsigned char smem[SMEM_BYTES];
  __shared__ uint4 xb_words;
  cg::grid_group grid = cg::this_grid();
  const int bid = blockIdx.x, nb = gridDim.x;
  if (threadIdx.x == 0) xb_words = make_uint4(0u, 0u, 0u, 0u);
  __syncthreads();
  (void)xcd_barrier_post(P.bar, (volatile LAS unsigned*)&xb_words);
  phase0(P, smem, bid, nb);
#if PROBE == 17
  phase0(P, smem, bid, nb);
#endif
  if (ph_end < 0) grid.sync();
  {
    XcdBarrier xb0; xb0.bar = P.bar; xb0.x = xb_xcc_id(); xb0.st = (volatile LAS unsigned*)&xb_words;
    xcd_barrier(xb0);
  }
  for (int ph = ph_begin + 1; ph < ph_end; ++ph) {
    XcdBarrier xb; xb.bar = P.bar; xb.x = xb_xcc_id(); xb.st = (volatile LAS unsigned*)&xb_words;
    run_phase(P, ph, smem, bid, nb, &xb);
    if (ph + 1 < ph_end) xcd_barrier(xb);
#if PROBE == 4
    xcd_barrier(xb); xcd_barrier(xb);
#endif
  }
}

extern "C" void kernel_launch(void* const* d_in, const int* in_sizes, int n_in, void* d_out, int out_size, void* d_ws,
                              size_t ws_size, hipStream_t stream) {
  Params P{};
  const float** pp = (const float**)&P;
  for (int i = 0; i < 29; ++i) pp[i] = (const float*)d_in[i];
  P.out = (float*)d_out;
  char* ws = (char*)d_ws;
  size_t off = 0;
  auto take = [&](size_t bytes) { char* p = ws + off; off += (bytes + 255) & ~(size_t)255; return p; };
  P.counters = (unsigned*)take(256);
  P.bar = (unsigned*)take(XCD_BAR_WORDS * 4);
  P.cucnt = (unsigned*)take(4096 * 4);
  P.lamv = (float*)take(256);
  P.mod = (float*)take((size_t)NL * 17 * 6144 * 4);
  P.ropeA = (float*)take(64 * 16 * 2 * 4);
  P.ropeD = (float*)take(64 * 8 * 2 * 4);
  P.ropeR = (float*)take(2048 * 32 * 2 * 4);
  P.cbuf = (float*)take((size_t)2 * MALL * 4 * 4);
  P.w_in_t = (u16*)take((size_t)INWP * D * 2);
  P.w_out_t = (u16*)take((size_t)D * D * 2);
  P.ffn_in_t = (u16*)take((size_t)2 * DFF * D * 2);
  P.ffn_out_t = (u16*)take((size_t)D * DFF * 2);
  P.zctx = (float*)take((size_t)NBATCH * CTX * D * 4);
  P.pbuf = (u16*)take((size_t)MALL * INW * 2);
  P.abuf = (u16*)take((size_t)MALL * D * 2);
  P.yd = (u16*)take((size_t)2 * MALL * 256 * 2);
  P.vt = (u16*)take((size_t)NBATCH * 10 * 64 * TALL * 2);
  P.stats = (float*)take((size_t)MALL * 2 * 4);
  if (off > ws_size) fprintf(stderr, "workspace too small: need %zu have %zu\n", off, ws_size);

  static int grid_blocks = 0;
  if (!grid_blocks) {
    int dev = 0, cus = 0, per_cu = 0;
    (void)hipGetDevice(&dev);
    (void)hipDeviceGetAttribute(&cus, hipDeviceAttributeMultiprocessorCount, dev);
    (void)hipOccupancyMaxActiveBlocksPerMultiprocessor(&per_cu, fwd_megakernel, 256, 0);
    if (per_cu > 2) per_cu = 2;
    if (per_cu < 1) per_cu = 1;
    grid_blocks = cus * per_cu;
  }
  (void)hipMemsetAsync(P.counters, 0, 256 + XCD_BAR_WORDS * 4 + 4096 * 4, stream);
  int ph_begin = 0, ph_end = 2 + 9 * NL;
  void* args[] = {&P, &ph_begin, &ph_end};
  hipError_t e = hipLaunchCooperativeKernel((void*)fwd_megakernel, dim3(grid_blocks), dim3(256), args, 0, stream);
  if (e != hipSuccess) fprintf(stderr, "cooperative launch failed: %s (grid %d)\n", hipGetErrorString(e), grid_blocks);
}
```

```cpp
#include <hip/hip_runtime.h>
#include <hip/hip_cooperative_groups.h>
#include <cstdio>
#ifndef PROBE
#define PROBE 0
#endif
#ifndef SCAN_PM
#define SCAN_PM 0
#endif
namespace cg = cooperative_groups;

typedef unsigned short u16;
using bf16x8 = __attribute__((ext_vector_type(8))) short;
using f32x16 = __attribute__((ext_vector_type(16))) float;
using u32x4 = __attribute__((ext_vector_type(4))) unsigned;
#define DI __device__ __forceinline__
#define MFMA32(a, b, c) __builtin_amdgcn_mfma_f32_32x32x16_bf16((a), (b), (c), 0, 0, 0)

static constexpr int D = 1024, NBATCH = 16, SEQ = 2048, CTX = 256, TALL = 2304, MALL = 36864, NL = 4;
static constexpr int INW = 3264, INWP = 3328, DFF = 2816;
static constexpr float ALPHA = 1.681792830507429f;
static constexpr float LOG2E = 1.4426950408889634f;
static constexpr int SMEM_BYTES = 79872;
static constexpr int NWCONV = 3200;

struct Params {
  const float *x, *c, *ctx, *c_ctx, *ada_w, *ada_b, *w_in, *rwkv_mu, *rwkv_w0, *rwkv_w_up, *rwkv_a0, *rwkv_a_up,
      *rwkv_g_up, *rwkv_k_k, *rwkv_k_a, *rwkv_r_k, *rwkv_ln_g, *rwkv_ln_b, *gqa_q_norm, *gqa_k_norm, *diff_lambda,
      *diff_norm, *w_out, *post1_g, *post1_b, *ffn_w_in, *ffn_w_out, *post2_g, *post2_b;
  float* out;
  unsigned* counters;
  unsigned* bar;
  unsigned* cucnt;
  float *lamv, *mod, *ropeA, *ropeD, *ropeR, *cbuf;
  u16 *w_in_t, *w_out_t, *ffn_in_t, *ffn_out_t;
  float* zctx;
  u16 *pbuf, *abuf;
  u16* yd;
  u16* vt;
  float* stats;
};

DI u16 f2bf(float x) { unsigned u = __float_as_uint(x); u += 0x7fffu + ((u >> 16) & 1u); return (u16)(u >> 16); }
DI float bf2f(u16 v) { return __uint_as_float(((unsigned)v) << 16); }
typedef __bf16 bf16v2 __attribute__((ext_vector_type(2)));
typedef float f32v2 __attribute__((ext_vector_type(2)));
DI unsigned pack2(float a, float b) { f32v2 v = {a, b}; bf16v2 r = __builtin_convertvector(v, bf16v2); return __builtin_bit_cast(unsigned, r); }
DI int opaque_tid() { int t = threadIdx.x; asm volatile("" : "+v"(t)); return t; }
DI int crow(int i, int h) { return (i & 3) + 8 * (i >> 2) + 4 * h; }
DI float dpp_f(float x, const int ctrl_sel) {
  int v = __float_as_int(x), r;
  if (ctrl_sel == 0) r = __builtin_amdgcn_update_dpp(0, v, 0xB1, 0xF, 0xF, true);
  else if (ctrl_sel == 1) r = __builtin_amdgcn_update_dpp(0, v, 0x4E, 0xF, 0xF, true);
  else r = __builtin_amdgcn_update_dpp(0, v, 0x141, 0xF, 0xF, true);
  return __int_as_float(r);
}
DI float xhalf_max(float x) {
  const auto r_ = __builtin_amdgcn_permlane32_swap(__float_as_uint(x), __float_as_uint(x), false, false);
  return fmaxf(__uint_as_float(r_[0]), __uint_as_float(r_[1]));
}
DI float xhalf_sum(float x) {
  const auto r_ = __builtin_amdgcn_permlane32_swap(__float_as_uint(x), __float_as_uint(x), false, false);
  return __uint_as_float(r_[0]) + __uint_as_float(r_[1]);
}
DI float reduce8(float x) { x += dpp_f(x, 0); x += dpp_f(x, 1); x += dpp_f(x, 2); return x; }
DI float wave_sum(float x) {
  x += dpp_f(x, 0); x += dpp_f(x, 1); x += dpp_f(x, 2);
  x += __int_as_float(__builtin_amdgcn_update_dpp(0, __float_as_int(x), 0x140, 0xF, 0xF, true));
  const int xi = __float_as_int(x);
  const float a = __int_as_float(__builtin_amdgcn_readlane(xi, 0)), b = __int_as_float(__builtin_amdgcn_readlane(xi, 16));
  const float c = __int_as_float(__builtin_amdgcn_readlane(xi, 32)), d = __int_as_float(__builtin_amdgcn_readlane(xi, 48));
  return (a + b) + (c + d);
}
DI float* xrow_ptr(const Params& P, int m) {
  int b = m / TALL, t = m - b * TALL;
  return t < CTX ? P.zctx + ((size_t)(b * CTX + t)) * D : P.out + ((size_t)(b * SEQ + t - CTX)) * D;
}


#define XB_TMO      128
#define XB_XCNT(j)  (256  + 64 * (j))
#define XB_XSUB(j)  (1280 + 64 * (j))
#define XB_XGEN(j)  (2304 + 64 * (j))
#define XB_TOP      3328
#define XB_TOPGEN   3392
#define XCD_BAR_WORDS 3456
#define XB_SPIN_CAP (1u << 20)
#define LAS __attribute__((address_space(3)))
DI unsigned xb_ld(unsigned* p) { return __hip_atomic_load(p, __ATOMIC_RELAXED, __HIP_MEMORY_SCOPE_AGENT); }
DI unsigned xb_add(unsigned* p, unsigned v) { return __hip_atomic_fetch_add(p, v, __ATOMIC_RELAXED, __HIP_MEMORY_SCOPE_AGENT); }
DI unsigned xb_xcc_id() { return (unsigned)__builtin_amdgcn_s_getreg((3 << 11) | 20) & 0xFu; }
#define XB_SPIN(cond, bar) do { unsigned _sp = 0; while (cond) { __builtin_amdgcn_s_sleep(1); \
    if ((++_sp & 255u) == 0u) { if (xb_ld(&(bar)[XB_TMO])) break; if (_sp > XB_SPIN_CAP) { atomicAdd(&(bar)[XB_TMO], 1u); break; } } } } while (0)
struct XcdBarrier { unsigned* bar; unsigned x; volatile LAS unsigned* st; };
DI XcdBarrier xcd_barrier_post(unsigned* bar, volatile LAS unsigned* st) {
  XcdBarrier b; b.bar = bar; b.x = xb_xcc_id(); b.st = st;
  if (threadIdx.x == 0) (void)xb_add(&bar[XB_XCNT(b.x)], 1u);
  return b;
}
DI void xcd_barrier_complete(unsigned* bar, unsigned x, unsigned& nloc, unsigned& nx) {
  const unsigned G = gridDim.x * gridDim.y * gridDim.z;
  unsigned sum, cnt, mine, sp = 0u;
  for (;;) {
    sum = 0u; cnt = 0u; mine = 0u;
#pragma unroll
    for (unsigned j = 0; j < 16; ++j) { const unsigned c = xb_ld(&bar[XB_XCNT(j)]); sum += c; cnt += (c > 0u) ? 1u : 0u; mine = (j == x) ? c : mine; }
    if (sum == G) break;
    __builtin_amdgcn_s_sleep(1);
    if ((++sp & 255u) == 0u) { if (xb_ld(&bar[XB_TMO])) break; if (sp > XB_SPIN_CAP) { atomicAdd(&bar[XB_TMO], 1u); break; } }
  }
  nloc = mine > 0u ? mine : 1u; nx = cnt > 0u ? cnt : 1u;
}
DI void xcd_barrier(const XcdBarrier& b) {
  asm volatile("s_waitcnt vmcnt(0)" ::: "memory");
  __syncthreads();
  if (threadIdx.x == 0) {
    unsigned* bar = b.bar;
    __builtin_amdgcn_s_waitcnt(0);
    unsigned nloc = b.st[0], nx = b.st[1];
    if (nloc == 0u) { xcd_barrier_complete(bar, b.x, nloc, nx); b.st[0] = nloc; b.st[1] = nx; }
    const unsigned old = xb_add(&bar[XB_XSUB(b.x)], 1u);
    const unsigned gen = old / nloc;
    if (old + 1u == (gen + 1u) * nloc) {
      __builtin_amdgcn_fence(__ATOMIC_RELEASE, "agent");
      asm volatile("s_waitcnt vmcnt(0)" ::: "memory");
      const unsigned og = xb_add(&bar[XB_TOP], 1u);
      const unsigned tg = og / nx;
      if (og + 1u == (tg + 1u) * nx) xb_add(&bar[XB_TOPGEN], 1u);
      else XB_SPIN(xb_ld(&bar[XB_TOPGEN]) == tg, bar);
      __builtin_amdgcn_fence(__ATOMIC_ACQUIRE, "agent");
      xb_add(&bar[XB_XGEN(b.x)], 1u);
      asm volatile("s_waitcnt vmcnt(0)" ::: "memory");
    } else {
      XB_SPIN(xb_ld(&bar[XB_XGEN(b.x)]) == gen, bar);
      __builtin_amdgcn_fence(__ATOMIC_ACQUIRE, "agent");
      asm volatile("s_waitcnt vmcnt(0)" ::: "memory");
    }
  }
  __syncthreads();
}

__device__ void wconv_tile(const Params& P, int l, int tile, unsigned char* smem) {
  float* T = (float*)smem;
  const int tid = opaque_tid();
  const float* src; u16* dst; int ldN, ldK, k0, n0; int kind;
  if (tile < 832) { kind = 0; int nt = tile >> 4, kt = tile & 15; src = P.w_in + (size_t)l * D * INW; ldN = INW; dst = P.w_in_t; ldK = D; k0 = kt * 64; n0 = nt * 64; }
  else if (tile < 1088) { kind = 1; int t = tile - 832; int nt = t >> 4, kt = t & 15; src = P.w_out + (size_t)l * D * D; ldN = D; dst = P.w_out_t; ldK = D; k0 = kt * 64; n0 = nt * 64; }
  else if (tile < 2496) { kind = 2; int t = tile - 1088; int nt = t >> 4, kt = t & 15; src = P.ffn_w_in + (size_t)l * D * (2 * DFF); ldN = 2 * DFF; dst = P.ffn_in_t; ldK = D; k0 = kt * 64; n0 = nt * 64; }
  else { kind = 3; int t = tile - 2496; int nt = t / 44, kt = t - nt * 44; src = P.ffn_w_out + (size_t)l * DFF * D; ldN = D; dst = P.ffn_out_t; ldK = DFF; k0 = kt * 64; n0 = nt * 64; }
  const int j = tid & 63, g = tid >> 6;
  int scol;
  bool zero = false;
  if (kind == 2) { int blk = n0 >> 7, w = (n0 >> 6) & 1; int hb = blk * 64 + w * 32; scol = (j < 32) ? hb + j : DFF + hb + (j - 32); }
  else { scol = n0 + j; if (kind == 0 && scol >= INW) zero = true; }
#pragma unroll 4
  for (int i = 0; i < 16; ++i) {
    int kr = g + 4 * i;
    T[kr * 65 + j] = zero ? 0.f : src[(size_t)(k0 + kr) * ldN + scol];
  }
  __syncthreads();
#pragma unroll 4
  for (int i = 0; i < 16; ++i) {
    int jr = g + 4 * i;
    dst[(size_t)(n0 + jr) * ldK + k0 + j] = f2bf(T[j * 65 + jr]);
  }
  __syncthreads();
}

__device__ void phase0(const Params& P, unsigned char* smem, int bid, int nb) {
  const int tid = opaque_tid();
  const int total = 384 + 256 + 1;
  for (int item = bid; item < total; item += nb) {
    if (item < 384) {
      const int l = item / 96, col0 = (item - l * 96) * 64;
      float* sc = (float*)smem;
      for (int i = tid; i < 17 * 1024; i += 256) {
        int r = i >> 10, k = i & 1023;
        float v = r < 16 ? P.c[r * 1024 + k] : P.c_ctx[k];
        sc[i] = v / (1.f + expf(-v));
      }
      __syncthreads();
      const int col = tid & 63, kq = tid >> 6;
      float acc[17];
#pragma unroll
      for (int r = 0; r < 17; ++r) acc[r] = 0.f;
      const float* w = P.ada_w + ((size_t)l * 1024 + kq * 256) * 6144 + col0 + col;
#pragma unroll 2
      for (int k = 0; k < 256; k += 4) {
        float w0 = w[(size_t)(k + 0) * 6144], w1 = w[(size_t)(k + 1) * 6144], w2 = w[(size_t)(k + 2) * 6144], w3 = w[(size_t)(k + 3) * 6144];
#pragma unroll
        for (int r = 0; r < 17; ++r) {
          float4 s = *(const float4*)(sc + r * 1024 + kq * 256 + k);
          acc[r] += s.x * w0 + s.y * w1 + s.z * w2 + s.w * w3;
        }
      }
      __syncthreads();
      float* red = (float*)smem;
#pragma unroll
      for (int r = 0; r < 17; ++r) red[(kq * 17 + r) * 64 + col] = acc[r];
      __syncthreads();
      for (int i = tid; i < 17 * 64; i += 256) {
        int r = i >> 6, cc = i & 63;
        float s = red[(0 * 17 + r) * 64 + cc] + red[(1 * 17 + r) * 64 + cc] + red[(2 * 17 + r) * 64 + cc] + red[(3 * 17 + r) * 64 + cc];
        P.mod[((size_t)(l * 17 + r)) * 6144 + col0 + cc] = s + P.ada_b[l * 6144 + col0 + cc];
      }
      __syncthreads();
    } else if (item < 384 + 256) {
      int e = (item - 384) * 256 + tid;
      int pos = e >> 5, i = e & 31;
      double inv = pow(10000.0, -2.0 * (double)i / 64.0);
      double ang = (double)pos * inv;
      P.ropeR[e * 2] = (float)cos(ang);
      P.ropeR[e * 2 + 1] = (float)sin(ang);
    } else {
      for (int e = tid; e < 64 * 16; e += 256) {
        int pos = e >> 4, i = e & 15;
        double ang = (double)pos * pow(10000.0, -2.0 * (double)i / 32.0);
        P.ropeA[e * 2] = (float)cos(ang); P.ropeA[e * 2 + 1] = (float)sin(ang);
      }
      for (int e = tid; e < 64 * 8; e += 256) {
        int pos = e >> 3, i = e & 7;
        double ang = (double)pos * pow(10000.0, -2.0 * (double)i / 16.0);
        P.ropeD[e * 2] = (float)cos(ang); P.ropeD[e * 2 + 1] = (float)sin(ang);
      }
      if (tid < NL) {
        const float* dl = P.diff_lambda + tid * 128;
        float s1 = 0.f, s2 = 0.f;
        for (int i = 0; i < 32; ++i) { s1 += dl[i] * dl[32 + i]; s2 += dl[64 + i] * dl[96 + i]; }
        float li = (float)(0.8 - 0.6 * exp(-0.3 * (double)tid));
        P.lamv[tid * 2] = expf(s1) - expf(s2) + li;
        P.lamv[tid * 2 + 1] = li;
      }
    }
  }
}

__device__ void phase_prep(const Params& P, int l, int mode, int bid, int nb, const int dummy = 0) {
  const int tid = opaque_tid();
  const int lane = tid & 63, wave = tid >> 6;
  const bool latent_only = (mode == 2) || (mode == 1 && l == NL - 1);
  const bool do_ln = !(mode == 0 && l == 0);
  const float* lg = P.post1_g; const float* lb = P.post1_b;
  if (mode == 0) { if (l > 0) { lg = P.post2_g + (l - 1) * D; lb = P.post2_b + (l - 1) * D; } }
  else if (mode == 1) { lg = P.post1_g + l * D; lb = P.post1_b + l * D; }
  else { lg = P.post2_g + (NL - 1) * D; lb = P.post2_b + (NL - 1) * D; }
  const int shofs = (mode == 0) ? 0 : 3 * D, scofs = shofs + D;
  const int mstep = nb * 4;
  int mn = bid * 4 + wave;
  while (mn < MALL && latent_only && (mn % TALL) < CTX) mn += mstep;
  float4 nv0 = make_float4(0.f, 0.f, 0.f, 0.f), nv1 = nv0, nv2 = nv0, nv3 = nv0;
  if (mn < MALL) {
    const int b = mn / TALL, t = mn - b * TALL; const bool isctx = t < CTX;
    const float* src = do_ln ? (isctx ? P.zctx + ((size_t)(b * CTX + t)) * D : P.out + ((size_t)(b * SEQ + t - CTX)) * D)
                             : (isctx ? P.ctx + ((size_t)(b * CTX + t)) * D : P.x + ((size_t)(b * SEQ + t - CTX)) * D);
    nv0 = *(const float4*)(src + lane * 4); nv1 = *(const float4*)(src + 256 + lane * 4); nv2 = *(const float4*)(src + 512 + lane * 4); nv3 = *(const float4*)(src + 768 + lane * 4);
  }
  while (mn < MALL) {
    const int m = mn;
    const int b = m / TALL, t = m - b * TALL;
    const bool isctx = t < CTX;
    float* xr = isctx ? P.zctx + ((size_t)(b * CTX + t)) * D : P.out + ((size_t)(b * SEQ + t - CTX)) * D;
    float4 v[4];
    v[0] = nv0; v[1] = nv1; v[2] = nv2; v[3] = nv3;
    mn += mstep;
    while (mn < MALL && latent_only && (mn % TALL) < CTX) mn += mstep;
    if (mn < MALL) {
      const int b2 = mn / TALL, t2 = mn - b2 * TALL; const bool c2 = t2 < CTX;
      const float* src = do_ln ? (c2 ? P.zctx + ((size_t)(b2 * CTX + t2)) * D : P.out + ((size_t)(b2 * SEQ + t2 - CTX)) * D)
                               : (c2 ? P.ctx + ((size_t)(b2 * CTX + t2)) * D : P.x + ((size_t)(b2 * SEQ + t2 - CTX)) * D);
      nv0 = *(const float4*)(src + lane * 4); nv1 = *(const float4*)(src + 256 + lane * 4); nv2 = *(const float4*)(src + 512 + lane * 4); nv3 = *(const float4*)(src + 768 + lane * 4);
    }
    float4 v0s[4];
    if (dummy) {
#pragma unroll
      for (int i = 0; i < 4; ++i) v0s[i] = v[i];
    }
    if (do_ln) {
      float s = 0.f;
#pragma unroll
      for (int i = 0; i < 4; ++i) s += v[i].x + v[i].y + v[i].z + v[i].w;
      const float mean = wave_sum(s) * (1.f / 1024.f);
      float q = 0.f;
#pragma unroll
      for (int i = 0; i < 4; ++i) { v[i].x -= mean; v[i].y -= mean; v[i].z -= mean; v[i].w -= mean; q += v[i].x * v[i].x + v[i].y * v[i].y + v[i].z * v[i].z + v[i].w * v[i].w; }
      const float rstd = rsqrtf(wave_sum(q) * (1.f / 1024.f) + 1e-5f);
      if (mode != 2 && lane == 0) *(float2*)(P.stats + (size_t)m * 2) = make_float2(mean, rstd);
#pragma unroll
      for (int i = 0; i < 4; ++i) {
        float4 g4 = *(const float4*)(lg + i * 256 + lane * 4), b4 = *(const float4*)(lb + i * 256 + lane * 4);
        v[i].x = v[i].x * rstd * g4.x + b4.x; v[i].y = v[i].y * rstd * g4.y + b4.y; v[i].z = v[i].z * rstd * g4.z + b4.z; v[i].w = v[i].w * rstd * g4.w + b4.w;
      }
    }
    if (dummy) {
#pragma unroll
      for (int i = 0; i < 4; ++i) { asm volatile("" :: "v"(v[i].x), "v"(v[i].y), "v"(v[i].z), "v"(v[i].w)); v[i] = v0s[i]; }
    }
    if (mode == 2 || dummy) {
#pragma unroll
      for (int i = 0; i < 4; ++i) *(float4*)(xr + i * 256 + lane * 4) = v[i];
    }
    if (mode != 2) {
      const int modrow = isctx ? 16 : b;
      const float* md = P.mod + ((size_t)(l * 17 + modrow)) * 6144;
#pragma unroll
      for (int i = 0; i < 4; ++i) {
        float4 sh = *(const float4*)(md + shofs + i * 256 + lane * 4), sc = *(const float4*)(md + scofs + i * 256 + lane * 4);
        uint2 o;
        o.x = pack2(v[i].x * (1.f + sc.x) + sh.x, v[i].y * (1.f + sc.y) + sh.y);
        o.y = pack2(v[i].z * (1.f + sc.z) + sh.z, v[i].w * (1.f + sc.w) + sh.w);
        *(uint2*)(P.abuf + (size_t)m * D + i * 256 + lane * 4) = o;
      }
    }
  }
}

enum { EPI_P = 0, EPI_RES1 = 1, EPI_RES2 = 2, EPI_SWIGLU = 3 };
template <int EPI, bool latent_only>
__device__ void phase_gemm(const Params& P, int l, const u16* __restrict__ A, const u16* __restrict__ Bt, const int K,
                           const int NT, unsigned char* smem, int bid, int nb, const int dummy = 0) {
  u16* sA = (u16*)smem;
  u16* sB = sA + 2 * 128 * 72;
  const int tid = opaque_tid(), lane = tid & 63, wave = tid >> 6, r = lane & 31, h = lane >> 5, wm = wave >> 1, wn = wave & 1;
  const int MT = latent_only ? 256 : 288;
  const int total = MT * NT, KT = K >> 6;
  const int lrow = tid >> 3, lkc = tid & 7;
  const bool swz = ((nb & 7) == 0);
  const int qstart = swz ? (bid >> 3) : bid, qstep = swz ? (nb >> 3) : nb, qtotal = swz ? (MT >> 3) * NT : total;
  for (int q = qstart; q < qtotal; q += qstep) {
    int mq, nt;
    if (swz) {
      const int MTX = MT >> 3, per_sr = 8 * NT;
      const int sr = q / per_sr, rem = q - sr * per_sr;
      const int gm = min(8, MTX - sr * 8);
      nt = rem / gm; mq = sr * 8 + (rem - nt * gm);
    } else { mq = q / NT; nt = q - mq * NT; }
    const int mi_ = swz ? (mq * 8 + (bid & 7)) : mq;
    const int mt = latent_only ? ((mi_ >> 4) * 18 + 2 + (mi_ & 15)) : mi_;
    const int m0 = mt * 128, n0 = nt * 128;
    f32x16 acc[2][2];
#pragma unroll
    for (int a = 0; a < 2; ++a)
#pragma unroll
      for (int b = 0; b < 2; ++b)
#pragma unroll
        for (int i = 0; i < 16; ++i) acc[a][b][i] = 0.f;
    const u16* Ag = A + (size_t)(m0 + lrow) * K + lkc * 8;
    const u16* Bg = Bt + (size_t)(n0 + lrow) * K + lkc * 8;
    const size_t K32 = (size_t)32 * K;
    uint4 xa0, xa1, xa2, xa3, xb0, xb1, xb2, xb3;
    uint4 ya0, ya1, ya2, ya3, yb0, yb1, yb2, yb3;
#define G_LOAD(S, kt_) { const int ko_ = (kt_) * 64; \
      S##a0 = *(const uint4*)(Ag + ko_); S##a1 = *(const uint4*)(Ag + K32 + ko_); S##a2 = *(const uint4*)(Ag + 2 * K32 + ko_); S##a3 = *(const uint4*)(Ag + 3 * K32 + ko_); \
      S##b0 = *(const uint4*)(Bg + ko_); S##b1 = *(const uint4*)(Bg + K32 + ko_); S##b2 = *(const uint4*)(Bg + 2 * K32 + ko_); S##b3 = *(const uint4*)(Bg + 3 * K32 + ko_); }
#define G_STORE(S, st_) { u16* sa_ = sA + (st_) * (128 * 72) + lrow * 72 + lkc * 8; u16* sb_ = sB + (st_) * (128 * 72) + lrow * 72 + lkc * 8; \
      *(uint4*)(sa_) = S##a0; *(uint4*)(sa_ + 32 * 72) = S##a1; *(uint4*)(sa_ + 64 * 72) = S##a2; *(uint4*)(sa_ + 96 * 72) = S##a3; \
      *(uint4*)(sb_) = S##b0; *(uint4*)(sb_ + 32 * 72) = S##b1; *(uint4*)(sb_ + 64 * 72) = S##b2; *(uint4*)(sb_ + 96 * 72) = S##b3; }
#define G_COMPUTE(st_) { \
      const u16* a_ = sA + (st_) * (128 * 72) + (wm * 64 + r) * 72 + h * 8; \
      const u16* b_ = sB + (st_) * (128 * 72) + (wn * 64 + r) * 72 + h * 8; \
      __builtin_amdgcn_s_setprio(1); \
      _Pragma("unroll") for (int ks = 0; ks < 4; ++ks) { \
        bf16x8 a0 = *(const bf16x8*)(a_ + ks * 16), a1 = *(const bf16x8*)(a_ + 32 * 72 + ks * 16); \
        bf16x8 b0 = *(const bf16x8*)(b_ + ks * 16), b1 = *(const bf16x8*)(b_ + 32 * 72 + ks * 16); \
        acc[0][0] = MFMA32(a0, b0, acc[0][0]); acc[0][1] = MFMA32(a0, b1, acc[0][1]); \
        acc[1][0] = MFMA32(a1, b0, acc[1][0]); acc[1][1] = MFMA32(a1, b1, acc[1][1]); } \
      __builtin_amdgcn_s_setprio(0); }
    G_LOAD(x, 0);
    G_STORE(x, 0);
    __syncthreads();
    if (KT > 1) G_LOAD(x, 1);
    for (int kt = 0; kt < KT; kt += 2) {
      if (kt + 2 < KT && dummy != 2) G_LOAD(y, kt + 2);
      G_COMPUTE(0);
      if (kt + 1 < KT && dummy != 2) G_STORE(x, 1);
      __syncthreads();
      if (kt + 1 >= KT) break;
      if (kt + 3 < KT && dummy != 2) G_LOAD(x, kt + 3);
      G_COMPUTE(1);
      if (kt + 2 < KT && dummy != 2) G_STORE(y, 0);
      __syncthreads();
    }
#undef G_LOAD
#undef G_STORE
#undef G_COMPUTE
    int m0e = m0, n0e = n0;
    asm volatile("" : "+s"(m0e), "+s"(n0e));
    int rb = wm * 64 + 4 * h, cb = wn * 64 + r;
    asm volatile("" : "+v"(rb), "+v"(cb));
    if (EPI == EPI_P) {
      const int wc0 = n0e + (cb & 64);
      int vh = -1;
      if (wc0 >= 1344 && wc0 < 1472) vh = (wc0 - 1344) >> 6;
      else if (wc0 >= 1984 && wc0 < 2240) vh = 2 + ((wc0 - 1984) >> 6);
      else if (wc0 >= 2752 && wc0 < 3008) vh = 6 + ((wc0 - 2752) >> 6);
      if (vh >= 0) {
        const int bb = m0e / TALL, t0 = m0e - bb * TALL;
#pragma unroll
        for (int mi = 0; mi < 2; ++mi)
#pragma unroll
          for (int ni = 0; ni < 2; ++ni)
#pragma unroll
            for (int g4 = 0; g4 < 4; ++g4) {
              const int d = ni * 32 + (cb & 31);
              const int tkn = t0 + (rb & 64) + mi * 32 + 8 * g4 + (rb & 63);
              const int q4 = (tkn >> 2) & 3;
              const int tk = (tkn & ~15) | ((q4 == 1 ? 2 : (q4 == 2 ? 1 : q4)) << 2);
              uint2 w;
              w.x = pack2(acc[mi][ni][4 * g4], acc[mi][ni][4 * g4 + 1]);
              w.y = pack2(acc[mi][ni][4 * g4 + 2], acc[mi][ni][4 * g4 + 3]);
              *(uint2*)(P.vt + ((size_t)((bb * 10 + vh) * 64 + d)) * TALL + tk) = w;
            }
      } else
#pragma unroll
      for (int mi = 0; mi < 2; ++mi)
#pragma unroll
        for (int ni = 0; ni < 2; ++ni) {
          const int col = n0e + cb + ni * 32;
          if (col < INW && (dummy < 2 || acc[mi][ni][0] == 12345.678f)) {
            const bool odd = (cb & 1) != 0;
#pragma unroll
            for (int i = 0; i < 16; i += 2) {
              const float a = acc[mi][ni][i], b2 = acc[mi][ni][i + 1];
              const float recv = dpp_f(odd ? a : b2, 0);
              const int row = m0e + rb + mi * 32 + (i & 3) + 8 * (i >> 2) + (odd ? 1 : 0);
              const unsigned w = odd ? pack2(recv, b2) : pack2(a, recv);
              *(unsigned*)(P.pbuf + (size_t)row * INW + (col & ~1)) = w;
            }
          }
        }
    } else if (EPI == EPI_RES1 || EPI == EPI_RES2) {
      const int b = m0e / TALL, t0 = m0e - b * TALL;
      const bool isctx = t0 < CTX;
      float* xb = isctx ? P.zctx + ((size_t)(b * CTX + t0)) * D : P.out + ((size_t)(b * SEQ + t0 - CTX)) * D;
      const float* g = P.mod + ((size_t)(l * 17 + (isctx ? 16 : b))) * 6144 + (EPI == EPI_RES1 ? 2 * D : 5 * D);
      const float* xs = (EPI == EPI_RES1 && l == 0) ? (isctx ? P.ctx + ((size_t)(b * CTX + t0)) * D : P.x + ((size_t)(b * SEQ + t0 - CTX)) * D) : xb;
      const float gv0 = g[n0e + cb], gv1 = g[n0e + cb + 32];
      const bool haveln = !(EPI == EPI_RES1 && l == 0);
      const float* lgp = (EPI == EPI_RES1) ? P.post2_g + (size_t)(l > 0 ? l - 1 : 0) * D : P.post1_g + (size_t)l * D;
      const float* lbp = (EPI == EPI_RES1) ? P.post2_b + (size_t)(l > 0 ? l - 1 : 0) * D : P.post1_b + (size_t)l * D;
      const float lg0 = lgp[n0e + cb], lg1 = lgp[n0e + cb + 32], lb0 = lbp[n0e + cb], lb1 = lbp[n0e + cb + 32];
#pragma unroll
      for (int mi = 0; mi < 2; ++mi) {
        float xo[2][16];
        float2 ms[16];
#pragma unroll
        for (int ni = 0; ni < 2; ++ni)
#pragma unroll
          for (int i = 0; i < 16; ++i)
            xo[ni][i] = xs[(size_t)(rb + mi * 32 + (i & 3) + 8 * (i >> 2)) * D + n0e + cb + ni * 32];
#pragma unroll
        for (int i = 0; i < 16; ++i)
          ms[i] = haveln ? *(const float2*)(P.stats + (size_t)(m0e + rb + mi * 32 + (i & 3) + 8 * (i >> 2)) * 2) : make_float2(0.f, 1.f);
        if (haveln) {
#pragma unroll
          for (int ni = 0; ni < 2; ++ni)
#pragma unroll
            for (int i = 0; i < 16; ++i) xo[ni][i] = (xo[ni][i] - ms[i].x) * ms[i].y * (ni ? lg1 : lg0) + (ni ? lb1 : lb0);
        }
#pragma unroll
        for (int ni = 0; ni < 2; ++ni)
#pragma unroll
          for (int i = 0; i < 16; ++i) {
            float* px = xb + (size_t)(rb + mi * 32 + (i & 3) + 8 * (i >> 2)) * D + n0e + cb + ni * 32;
            if (dummy == 3) { if (acc[mi][ni][i] == 12345.678f) *px = 0.f; }
            else {
              float xn = ALPHA * xo[ni][i] + (ni ? gv1 : gv0) * acc[mi][ni][i];
              if (dummy) { asm volatile("" :: "v"(xn)); xn = xo[ni][i]; }
              *px = xn;
            }
          }
      }
    } else {
      const int hb = (n0e >> 7) * 64 + (cb >> 6) * 32 + (cb & 31);
      const bool odd = (cb & 1) != 0;
#pragma unroll
      for (int mi = 0; mi < 2; ++mi)
#pragma unroll
        for (int i = 0; i < 16; i += 2) {
          const float u0 = acc[mi][0][i], g0 = acc[mi][1][i], u1 = acc[mi][0][i + 1], g1 = acc[mi][1][i + 1];
          const float a = u0 * __builtin_amdgcn_rcpf(1.f + __expf(-u0)) * g0, b2 = u1 * __builtin_amdgcn_rcpf(1.f + __expf(-u1)) * g1;
          const float recv = dpp_f(odd ? a : b2, 0);
          const int row = m0e + rb + mi * 32 + (i & 3) + 8 * (i >> 2) + (odd ? 1 : 0);
          const unsigned w = odd ? pack2(recv, b2) : pack2(a, recv);
          *(unsigned*)(P.pbuf + (size_t)row * DFF + (hb & ~1)) = w;
        }
    }
  }
}

__device__ void phase_attnprep(const Params& P, int l, unsigned char* smem, int bid, int nb, const int dummy = 0) {
  const int tid = opaque_tid(), lane = tid & 63, wave = tid >> 6;
  for (int m = bid * 4 + wave; m < MALL; m += nb * 4) {
    const int b = m / TALL, t = m - b * TALL;
    const bool isctx = t < CTX;
    const int tp = t - CTX, rowp = tp >> 6, colp = tp & 63;
    u16* pr = P.pbuf + (size_t)m * INW;
    float xv[22];
#pragma unroll
    for (int ch = 0; ch < 22; ++ch) {
      const int col = ch < 4 ? 960 + ch * 64 : (ch < 6 ? 1216 + (ch - 4) * 64 : (ch < 10 ? 1472 + (ch - 6) * 64 : (ch < 14 ? 1728 + (ch - 10) * 64 : (ch < 18 ? 2240 + (ch - 14) * 64 : 2496 + (ch - 18) * 64))));
      xv[ch] = bf2f(pr[col + lane]);
    }
    float csA = 1.f, snA = 0.f, csD = 1.f, snD = 0.f, csR = 1.f, snR = 0.f;
    if (!isctx) {
      { const int e = lane & 31, pos = (lane >> 5) ? colp : rowp, i = e & 15; csA = P.ropeA[(pos * 16 + i) * 2]; snA = P.ropeA[(pos * 16 + i) * 2 + 1]; if (e < 16) snA = -snA; }
      { const int e = lane & 15, pos = ((lane >> 4) & 1) ? colp : rowp, i = e & 7; csD = P.ropeD[(pos * 8 + i) * 2]; snD = P.ropeD[(pos * 8 + i) * 2 + 1]; if (e < 8) snD = -snD; }
      { const int i = lane & 31; csR = P.ropeR[(tp * 32 + i) * 2]; snR = P.ropeR[(tp * 32 + i) * 2 + 1]; if (lane < 32) snR = -snR; }
    }
    const float gq = P.gqa_q_norm[l * 64 + lane], gk = P.gqa_k_norm[l * 64 + lane];
#pragma unroll
    for (int ch = 0; ch < 22; ++ch) {
      const int col = ch < 4 ? 960 + ch * 64 : (ch < 6 ? 1216 + (ch - 4) * 64 : (ch < 10 ? 1472 + (ch - 6) * 64 : (ch < 14 ? 1728 + (ch - 10) * 64 : (ch < 18 ? 2240 + (ch - 14) * 64 : 2496 + (ch - 18) * 64))));
      float x = xv[ch];
      if (ch < 6) {
        const float ss = wave_sum(x * x);
        x = x * rsqrtf(ss * (1.f / 64.f) + 1e-6f) * (ch < 4 ? gq : gk);
        const float partner = __shfl_xor(x, 16);
        x = x * csA + partner * snA;
        if (ch < 4) x *= 0.125f * LOG2E;
      } else if (ch < 14) {
        const float partner = __shfl_xor(x, 8);
        x = x * csD + partner * snD;
        if (ch < 10) x *= 0.17677669529663687f * LOG2E;
      } else {
        const float partner = __shfl_xor(x, 32);
        x = x * csR + partner * snR;
        if (ch >= 18) x *= 0.125f;
      }
      if (dummy) { asm volatile("" :: "v"(x)); x = xv[ch]; }
      pr[col + lane] = f2bf(x);
    }
  }
}

__device__ void scan_item(const Params& P, int l, int item, unsigned char* smem, const int pm = 0) {
  float* prep = (float*)smem;
  u16* raw = (u16*)(smem + 49152);
  u16* twb = (u16*)(smem + 49152 + 17408);
  u16* tab = twb + 32 * 40;
  float* ybuf = (float*)(smem + 49152 + 17408 + 8192);
  const int tid = opaque_tid(), lane = tid & 63, wave = tid >> 6;
  __builtin_amdgcn_s_setprio(3);
  const int dir = item >> 7, b = (item >> 3) & 15, hh = (item >> 1) & 3, hf = item & 1;
  const int c = tid;
  int pcol;
  if (c < 64) pcol = hh * 64 + c; else if (c < 128) pcol = 256 + hh * 64 + (c - 64); else if (c < 192) pcol = 512 + hh * 64 + (c - 128);
  else if (c < 224) pcol = 768 + dir * 32 + (c - 192); else pcol = 832 + dir * 32 + (c - 224);
  const float mu = P.rwkv_mu[l * 960 + pcol];
  const int kB = tid & 63, tg = tid >> 6;
  const int wv = __builtin_amdgcn_readfirstlane(wave);
  bf16x8 bfr0, bfr1;
  {
    const float* up = ((wv >> 1) ? P.rwkv_a_up : P.rwkv_w_up) + ((size_t)((l * 2 + dir) * 32)) * 256 + hh * 64 + (wv & 1) * 32 + (lane & 31);
    const int hq = lane >> 5;
    u32x4 t0, t1;
#pragma unroll
    for (int jj = 0; jj < 4; ++jj) {
      t0[jj] = pack2(up[(size_t)(8 * hq + 2 * jj) * 256], up[(size_t)(8 * hq + 2 * jj + 1) * 256]);
      t1[jj] = pack2(up[(size_t)(16 + 8 * hq + 2 * jj) * 256], up[(size_t)(16 + 8 * hq + 2 * jj + 1) * 256]);
    }
    bfr0 = __builtin_bit_cast(bf16x8, t0); bfr1 = __builtin_bit_cast(bf16x8, t1);
  }
  const float w0 = P.rwkv_w0[(l * 2 + dir) * 256 + hh * 64 + kB], a0 = P.rwkv_a0[(l * 2 + dir) * 256 + hh * 64 + kB];
  const float ka = P.rwkv_k_a[l * 256 + hh * 64 + kB], rk = P.rwkv_r_k[(l * 4 + hh) * 64 + kB];
  const float kkwB = P.rwkv_k_k[l * 256 + hh * 64 + kB];
  const int vec = tid & 31;
  int vcol;
  if (vec < 8) vcol = hh * 64 + vec * 8; else if (vec < 16) vcol = 256 + hh * 64 + (vec - 8) * 8; else if (vec < 24) vcol = 512 + hh * 64 + (vec - 16) * 8;
  else if (vec < 28) vcol = 768 + dir * 32 + (vec - 24) * 8; else vcol = 832 + dir * 32 + (vec - 28) * 8;
  const u16* pb = P.pbuf + (size_t)(b * TALL) * INW + vcol;
  f32v2 S0 = {0.f, 0.f}, S1 = S0, S2 = S0, S3 = S0;
  const int rowl = wave * 8 + (lane >> 3), ks = lane & 7;
  uint4 rg0 = make_uint4(0, 0, 0, 0), rg1 = rg0, rg2 = rg0, rg3 = rg0, rg4 = rg0;

  for (int ch = -1; ch < 72; ++ch) {
    const int nx = ch + 1;
    const bool more = nx < 72;
    if (more) {
      const int n0 = nx * 32; const bool cx = n0 < 256;
      const int tlo = dir ? (cx ? 224 - n0 : 2528 - n0) : n0;
      const int slo = cx ? 0 : 256, shi = cx ? 256 : 2304;
      rg0 = *(const uint4*)(pb + (size_t)(tlo + (tid >> 5)) * INW);
      rg1 = *(const uint4*)(pb + (size_t)(tlo + (tid >> 5) + 8) * INW);
      rg2 = *(const uint4*)(pb + (size_t)(tlo + (tid >> 5) + 16) * INW);
      rg3 = *(const uint4*)(pb + (size_t)(tlo + (tid >> 5) + 24) * INW);
      rg4 = make_uint4(0, 0, 0, 0);
      if (tid < 64) { const int tok = (tid >> 5) ? tlo + 32 : tlo - 1; if (tok >= slo && tok < shi) rg4 = *(const uint4*)(pb + (size_t)tok * INW); }
    }
    if (ch >= 0 && !(pm & 1)) {
      {
        const float* psb = prep + ks * 8;
        const float* pvb = prep + 320 + hf * 32 + rowl;
        float4 nap0 = *(const float4*)(psb), nap1 = *(const float4*)(psb + 4);
        float4 nw0 = *(const float4*)(psb + 64), nw1 = *(const float4*)(psb + 68);
        float4 nbp0 = *(const float4*)(psb + 128), nbp1 = *(const float4*)(psb + 132);
        float4 nkd0 = *(const float4*)(psb + 192), nkd1 = *(const float4*)(psb + 196);
        float4 nr0 = *(const float4*)(psb + 256), nr1 = *(const float4*)(psb + 260);
        float nvv = pvb[0];
#pragma unroll 2
        for (int step = 0; step < 32; ++step) {
          const float4 ap0 = nap0, ap1 = nap1, w0v = nw0, w1v = nw1, bp0 = nbp0, bp1 = nbp1, kd0 = nkd0, kd1 = nkd1, r0 = nr0, r1 = nr1;
          const float vv = nvv;
          {
            const int nxs = (step < 31) ? step + 1 : 31;
            const float* ps = psb + nxs * 384;
            nap0 = *(const float4*)(ps); nap1 = *(const float4*)(ps + 4);
            nw0 = *(const float4*)(ps + 64); nw1 = *(const float4*)(ps + 68);
            nbp0 = *(const float4*)(ps + 128); nbp1 = *(const float4*)(ps + 132);
            nkd0 = *(const float4*)(ps + 192); nkd1 = *(const float4*)(ps + 196);
            nr0 = *(const float4*)(ps + 256); nr1 = *(const float4*)(ps + 260);
            nvv = pvb[nxs * 384];
          }
          f32v2 t = S0 * (f32v2){ap0.x, ap0.y};
          t = S1 * (f32v2){ap0.z, ap0.w} + t;
          t = S2 * (f32v2){ap1.x, ap1.y} + t;
          t = S3 * (f32v2){ap1.z, ap1.w} + t;
          const float sa = reduce8(t.x + t.y);
          const f32v2 sa2 = {sa, sa}, vv2 = {vv, vv};
          S0 = S0 * (f32v2){w0v.x, w0v.y} + (sa2 * (f32v2){bp0.x, bp0.y} + vv2 * (f32v2){kd0.x, kd0.y});
          S1 = S1 * (f32v2){w0v.z, w0v.w} + (sa2 * (f32v2){bp0.z, bp0.w} + vv2 * (f32v2){kd0.z, kd0.w});
          S2 = S2 * (f32v2){w1v.x, w1v.y} + (sa2 * (f32v2){bp1.x, bp1.y} + vv2 * (f32v2){kd1.x, kd1.y});
          S3 = S3 * (f32v2){w1v.z, w1v.w} + (sa2 * (f32v2){bp1.z, bp1.w} + vv2 * (f32v2){kd1.z, kd1.w});
          f32v2 u = S0 * (f32v2){r0.x, r0.y};
          u = S1 * (f32v2){r0.z, r0.w} + u;
          u = S2 * (f32v2){r1.x, r1.y} + u;
          u = S3 * (f32v2){r1.z, r1.w} + u;
          const float y = reduce8(u.x + u.y);
          if (ks == 0) ybuf[step * 32 + rowl] = y;
        }
      }
      __syncthreads();
      {
        const int step = tid >> 3, q = tid & 7;
        const int n = ch * 32 + step;
        const int tok = dir ? (n < 256 ? 255 - n : 2559 - n) : n;
        float4 yv = *(const float4*)(ybuf + step * 32 + q * 4);
        if (!(pm & 8)) { uint2 w; w.x = pack2(yv.x, yv.y); w.y = pack2(yv.z, yv.w); *(uint2*)(P.yd + ((size_t)(dir * MALL + b * TALL + tok)) * 256 + hh * 64 + hf * 32 + q * 4) = w; }
      }
    }
    if (more) {
      *(uint4*)(raw + (1 + (tid >> 5)) * 256 + vec * 8) = rg0;
      *(uint4*)(raw + (9 + (tid >> 5)) * 256 + vec * 8) = rg1;
      *(uint4*)(raw + (17 + (tid >> 5)) * 256 + vec * 8) = rg2;
      *(uint4*)(raw + (25 + (tid >> 5)) * 256 + vec * 8) = rg3;
      if (tid < 64) *(uint4*)(raw + ((tid >> 5) ? 33 : 0) * 256 + vec * 8) = rg4;
      __syncthreads();
      if (!(pm & 2)) {
        float pv[34];
#pragma unroll
        for (int j = 0; j < 34; ++j) pv[j] = bf2f(raw[j * 256 + c]);
        if (wv < 3) {
          float* pdst = prep + (wv == 0 ? 256 + c : (wv == 1 ? 192 + (c - 64) : 320 + (c - 128)));
#pragma unroll
          for (int j = 0; j < 32; ++j) {
            const float psv = pv[j + 1] + mu * (0.5f * (pv[j] + pv[j + 2]) - pv[j + 1]);
            pdst[(dir ? 31 - j : j) * 384] = psv;
          }
        } else {
          u16* tdst = ((c < 224) ? twb : tab) + ((c - 192) & 31);
#pragma unroll
          for (int j = 0; j < 32; ++j) {
            const float psv = pv[j + 1] + mu * (0.5f * (pv[j] + pv[j + 2]) - pv[j + 1]);
            const float th = 1.f - 2.f * __builtin_amdgcn_rcpf(__expf(2.f * psv) + 1.f);
            tdst[(dir ? 31 - j : j) * 40] = f2bf((c < 224) ? th : psv);
          }
        }
      }
      __syncthreads();
      if (!(pm & 4)) {
        const int r = lane & 31, hq = lane >> 5;
        const u16* asrc = ((wv >> 1) ? tab : twb) + r * 40 + 8 * hq;
        const bf16x8 af0 = *(const bf16x8*)(asrc), af1 = *(const bf16x8*)(asrc + 16);
        f32x16 accl;
#pragma unroll
        for (int i = 0; i < 16; ++i) accl[i] = 0.f;
        accl = MFMA32(af0, bfr0, accl);
        accl = MFMA32(af1, bfr1, accl);
        float* odst = prep + ((wv >> 1) ? 128 : 64) + (wv & 1) * 32 + r;
#pragma unroll
        for (int i = 0; i < 16; ++i) odst[crow(i, hq) * 384] = accl[i];
      }
      __syncthreads();
      if (!(pm & 4)) {
        const int n0 = nx * 32;
#pragma unroll 2
        for (int s = 0; s < 8; ++s) {
          const int step = tg * 8 + s;
          float* pp = prep + step * 384;
          const float wacc = w0 + pp[64 + kB], aacc = a0 + pp[128 + kB];
          const float sg = __builtin_amdgcn_rcpf(1.f + __expf(-wacc));
          const float decay = __expf(-0.6065306597126334f * sg);
          const float av = __builtin_amdgcn_rcpf(1.f + __expf(-aacc));
          const float ksv = pp[192 + kB];
          const float xk = ksv * kkwB;
          const float kk = xk * rsqrtf(fmaxf(wave_sum(xk * xk), 1e-24f));
          const float kd = ksv * (1.f + (av - 1.f) * ka);
          pp[64 + kB] = decay; pp[192 + kB] = kd; pp[128 + kB] = kk * av; pp[kB] = -kk;
          const float cs = wave_sum(pp[256 + kB] * kd * rk);
          if (lane == 0 && hf == 0 && !(pm & 8)) {
            const int n = n0 + step;
            const int tok = dir ? (n < 256 ? 255 - n : 2559 - n) : n;
            P.cbuf[((size_t)(dir * MALL + b * TALL + tok)) * 4 + hh] = cs;
          }
        }
      }
    }
    __syncthreads();
  }
  __builtin_amdgcn_s_setprio(0);
}

template <int KIND>
__device__ void attn_item(const Params& P, int l, int b, int hh, int qb, bool isctx, unsigned char* smem) {
  constexpr int NMAP = (KIND == 1) ? 2 : 1;
  constexpr int NKS = (KIND == 1) ? 2 : 4;
  u16* sK = (u16*)smem;
  u16* sV = sK + 2 * 64 * 72;
  float* stash = (float*)(smem + 4 * 64 * 72 * 2);
  const int tid = opaque_tid(), lane = tid & 63, wave = tid >> 6, r = lane & 31, h = lane >> 5;
  int qcol, kcol, vh, ycol;
  if (KIND == 0) { qcol = 960 + hh * 64; kcol = 1216 + (hh >> 1) * 64; vh = hh >> 1; ycol = 256 + hh * 64; }
  else if (KIND == 1) { qcol = 1472 + hh * 64; kcol = 1728 + hh * 64; vh = 2 + hh; ycol = 512 + hh * 64; }
  else { qcol = 2240 + hh * 64; kcol = 2496 + hh * 64; vh = 6 + hh; ycol = 768 + hh * 64; }
  const int iq = qb * 128 + wave * 32 + r;
  const int tq = b * TALL + (isctx ? 0 : CTX) + iq;
  const int ntiles = isctx ? 4 : 36;
  float lgf = 0.f, lgb = 0.f;
  if (KIND == 2) { lgf = log2f(1.f - exp2f(-5.f - (float)hh)); lgb = log2f(1.f - exp2f(-5.f - (float)(3 - hh))); }
  float cf[16], cb[16], ckf = 1.f, ckb = 1.f;
  if (KIND == 2) {
#pragma unroll
    for (int i = 0; i < 16; ++i) {
      const float o_ = (float)crow(i, h);
      cf[i] = __builtin_amdgcn_exp2f(-o_ * lgf);
      cb[i] = __builtin_amdgcn_exp2f(o_ * lgb);
    }
    ckf = __builtin_amdgcn_exp2f(-32.f * lgf); ckb = __builtin_amdgcn_exp2f(32.f * lgb);
  }
  const int q0w = qb * 128 + wave * 32;
  const int lrow = tid >> 3, lvec = tid & 7;
  const u16* Kg = P.pbuf + (size_t)(b * TALL + lrow) * INW + kcol + lvec * 8;
  const u16* Vg = P.vt + ((size_t)((b * 10 + vh) * 64 + lrow)) * TALL + lvec * 8;
  float o[2][16];
  {
    bf16x8 qf[NMAP][NKS];
    f32x16 O[NMAP][2];
    float mrun[NMAP], lsum[NMAP];
#pragma unroll
    for (int mp = 0; mp < NMAP; ++mp) {
      mrun[mp] = 0.f; lsum[mp] = 0.f;
#pragma unroll
      for (int ks = 0; ks < NKS; ++ks) qf[mp][ks] = *(const bf16x8*)(P.pbuf + (size_t)tq * INW + qcol + mp * 32 + ks * 16 + h * 8);
#pragma unroll
      for (int dt = 0; dt < 2; ++dt)
#pragma unroll
        for (int i = 0; i < 16; ++i) O[mp][dt][i] = 0.f;
    }
    uint4 xk0, xk1, xv0, xv1;
#define ATT_LOAD(S, t_) { S##k0 = *(const uint4*)(Kg + (size_t)((t_) * 64) * INW); S##k1 = *(const uint4*)(Kg + (size_t)((t_) * 64 + 32) * INW); \
      S##v0 = *(const uint4*)(Vg + (t_) * 64); S##v1 = *(const uint4*)(Vg + (size_t)32 * TALL + (t_) * 64); }
#define ATT_STORE(S, st_) { u16* k2 = sK + (st_) * (64 * 72); u16* v2 = sV + (st_) * (64 * 72); \
      *(uint4*)(k2 + lrow * 72 + lvec * 8) = S##k0; *(uint4*)(k2 + (lrow + 32) * 72 + lvec * 8) = S##k1; \
      *(uint4*)(v2 + lrow * 72 + lvec * 8) = S##v0; *(uint4*)(v2 + (lrow + 32) * 72 + lvec * 8) = S##v1; }
#define ATT_COMPUTE(t_, st_) { \
      const int t = (t_); \
      const u16* k_ = sK + (st_) * (64 * 72); \
      const u16* v_ = sV + (st_) * (64 * 72); \
      _Pragma("unroll") for (int mp = 0; mp < NMAP; ++mp) { \
      f32x16 st[2]; \
      const float sinit = (KIND != 2 && t > 0) ? -mrun[mp] : 0.f;     \
      _Pragma("unroll") for (int kt = 0; kt < 2; ++kt) { \
        _Pragma("unroll") for (int i = 0; i < 16; ++i) st[kt][i] = sinit; \
        _Pragma("unroll") for (int ks = 0; ks < NKS; ++ks) { \
          bf16x8 kf = *(const bf16x8*)(k_ + (kt * 32 + r) * 72 + mp * 32 + ks * 16 + h * 8); \
          st[kt] = MFMA32(kf, qf[mp][ks], st[kt]); \
        } \
      } \
      int rmode = 0; float rff = 0.f, rbb = 0.f; \
      if (KIND == 2) { \
        const int kb = t * 64 - (isctx ? 0 : 256); \
        if (!isctx && t < 4) { rmode = 3; rff = __builtin_amdgcn_exp2f((float)(iq - kb) * lgf); rbb = __builtin_amdgcn_exp2f((float)(2048 - iq + t * 64) * lgb); } \
        else if (kb + 63 < q0w) { rmode = 1; rff = __builtin_amdgcn_exp2f((float)(iq - kb) * lgf); } \
        else if (kb > q0w + 31) { rmode = 2; rbb = __builtin_amdgcn_exp2f((float)(kb - iq) * lgb); } \
      } \
      if (KIND != 2) { \
        float mx = st[0][0]; \
        _Pragma("unroll") for (int kt = 0; kt < 2; ++kt) \
          _Pragma("unroll") for (int i = 0; i < 16; ++i) mx = fmaxf(mx, st[kt][i]); \
        mx = xhalf_max(mx); \
        if (t == 0) {                        \
          mrun[mp] = mx; \
          _Pragma("unroll") for (int kt = 0; kt < 2; ++kt) \
            _Pragma("unroll") for (int i = 0; i < 16; ++i) st[kt][i] -= mx; \
        } else if (__builtin_amdgcn_ballot_w64(mx > 8.f) != 0ull) {     \
          const float delta = fmaxf(mx, 0.f); \
          const float alpha = __builtin_amdgcn_exp2f(-delta); \
          mrun[mp] += delta; \
          lsum[mp] *= alpha; \
          _Pragma("unroll") for (int kt = 0; kt < 2; ++kt) \
            _Pragma("unroll") for (int i = 0; i < 16; ++i) st[kt][i] -= delta; \
          _Pragma("unroll") for (int dt = 0; dt < 2; ++dt) \
            _Pragma("unroll") for (int i = 0; i < 16; ++i) O[mp][dt][i] *= alpha; \
        } \
      } \
      _Pragma("unroll") for (int kt = 0; kt < 2; ++kt) { \
        if (KIND != 2) { \
          f32v2 ps2 = {0.f, 0.f}; \
          _Pragma("unroll") for (int i = 0; i < 16; i += 2) { \
            const float p0 = __builtin_amdgcn_exp2f(st[kt][i]), p1 = __builtin_amdgcn_exp2f(st[kt][i + 1]); \
            st[kt][i] = p0; st[kt][i + 1] = p1; ps2 += (f32v2){p0, p1}; } \
          lsum[mp] += ps2.x + ps2.y; \
        } else if (rmode != 0) { \
          const float rf_ = kt ? rff * ckf : rff, rb_ = kt ? rbb * ckb : rbb; \
          _Pragma("unroll") for (int i = 0; i < 16; ++i) st[kt][i] *= rf_ * cf[i] + rb_ * cb[i]; \
        } else { \
          const int kbase = t * 64 - (isctx ? 0 : 256); \
          _Pragma("unroll") for (int i = 0; i < 16; ++i) { \
            const int df = iq - (kbase + kt * 32 + crow(i, h)); \
            const float e = __builtin_amdgcn_exp2f(df > 0 ? (float)df * lgf : (float)(-df) * lgb); \
            st[kt][i] *= (df == 0) ? 2.f : e; \
          } \
        } \
        _Pragma("unroll") for (int s = 0; s < 2; ++s) { \
          u32x4 pbu; \
          pbu[0] = pack2(st[kt][8 * s + 0], st[kt][8 * s + 1]); pbu[1] = pack2(st[kt][8 * s + 2], st[kt][8 * s + 3]); \
          pbu[2] = pack2(st[kt][8 * s + 4], st[kt][8 * s + 5]); pbu[3] = pack2(st[kt][8 * s + 6], st[kt][8 * s + 7]); \
          const bf16x8 pbv = __builtin_bit_cast(bf16x8, pbu); \
          _Pragma("unroll") for (int dt = 0; dt < 2; ++dt) { \
            const bf16x8 vfv = *(const bf16x8*)(v_ + (dt * 32 + r) * 72 + kt * 32 + s * 16 + 8 * h);     \
            O[mp][dt] = MFMA32(vfv, pbv, O[mp][dt]); \
          } \
        } \
      } \
      } }
    ATT_LOAD(x, 0);
    ATT_STORE(x, 0);
    __syncthreads();
    for (int tt = 0; tt < ntiles; ++tt) {
      const int cur = tt & 1;
      if (tt + 1 < ntiles) ATT_LOAD(x, tt + 1);
      ATT_COMPUTE(tt, cur);
      if (tt + 1 < ntiles) ATT_STORE(x, cur ^ 1);
      __syncthreads();
    }
#undef ATT_LOAD
#undef ATT_STORE
#undef ATT_COMPUTE
    if (KIND == 0) {
      const float inv = 1.f / (lsum[0] + __shfl_xor(lsum[0], 32));
#pragma unroll
      for (int dt = 0; dt < 2; ++dt)
#pragma unroll
        for (int i = 0; i < 16; ++i) o[dt][i] = O[0][dt][i] * inv;
    } else if (KIND == 1) {
      const float inv0 = 1.f / (lsum[0] + __shfl_xor(lsum[0], 32));
      const float inv1 = P.lamv[l * 2] / (lsum[NMAP - 1] + __shfl_xor(lsum[NMAP - 1], 32));
#pragma unroll
      for (int dt = 0; dt < 2; ++dt)
#pragma unroll
        for (int i = 0; i < 16; ++i) o[dt][i] = O[0][dt][i] * inv0 - O[NMAP - 1][dt][i] * inv1;
    } else {
#pragma unroll
      for (int dt = 0; dt < 2; ++dt)
#pragma unroll
        for (int i = 0; i < 16; ++i) o[dt][i] = O[0][dt][i];
    }
  }
  if (KIND == 1) {
    float ss = 0.f;
#pragma unroll
    for (int dt = 0; dt < 2; ++dt)
#pragma unroll
      for (int i = 0; i < 16; ++i) ss += o[dt][i] * o[dt][i];
    ss += __shfl_xor(ss, 32);
    const float sc = rsqrtf(ss * (1.f / 64.f) + 1e-6f) * (1.f - P.lamv[l * 2 + 1]);
#pragma unroll
    for (int dt = 0; dt < 2; ++dt)
#pragma unroll
      for (int i = 0; i < 16; ++i) o[dt][i] *= sc * P.diff_norm[l * 64 + dt * 32 + crow(i, h)];
  } else if (KIND == 2) {
    float s = 0.f;
#pragma unroll
    for (int dt = 0; dt < 2; ++dt)
#pragma unroll
      for (int i = 0; i < 16; ++i) s += o[dt][i];
    s += __shfl_xor(s, 32);
    const float mean = s * (1.f / 64.f);
    float q = 0.f;
#pragma unroll
    for (int dt = 0; dt < 2; ++dt)
#pragma unroll
      for (int i = 0; i < 16; ++i) { const float x = o[dt][i] - mean; o[dt][i] = x; q += x * x; }
    q += __shfl_xor(q, 32);
    const float rstd = rsqrtf(q * (1.f / 64.f) + 1e-5f);
#pragma unroll
    for (int dt = 0; dt < 2; ++dt)
#pragma unroll
      for (int g = 0; g < 4; ++g) {
        const int d0 = dt * 32 + 8 * g + 4 * h;
        const uint2 gt = *(const uint2*)(P.pbuf + (size_t)tq * INW + 3008 + hh * 64 + d0);
        const float g0 = bf2f((u16)(gt.x & 0xffff)), g1 = bf2f((u16)(gt.x >> 16)), g2 = bf2f((u16)(gt.y & 0xffff)), g3 = bf2f((u16)(gt.y >> 16));
        o[dt][4 * g + 0] *= rstd * g0 / (1.f + __expf(-g0));
        o[dt][4 * g + 1] *= rstd * g1 / (1.f + __expf(-g1));
        o[dt][4 * g + 2] *= rstd * g2 / (1.f + __expf(-g2));
        o[dt][4 * g + 3] *= rstd * g3 / (1.f + __expf(-g3));
      }
  }
#pragma unroll
  for (int dt = 0; dt < 2; ++dt)
#pragma unroll
    for (int g = 0; g < 4; ++g) {
      const int d0 = dt * 32 + 8 * g + 4 * h;
      uint2 w;
      w.x = pack2(o[dt][4 * g], o[dt][4 * g + 1]);
      w.y = pack2(o[dt][4 * g + 2], o[dt][4 * g + 3]);
      *(uint2*)(P.abuf + (size_t)tq * D + ycol + d0) = w;
    }
}

__device__ void phase_mixers(const Params& P, int l, unsigned char* smem, int cbase = 0, int mode = 0) {
  __shared__ int s_item;
  const int natt = (mode == 1 || mode == 3) ? 0 : 3072 + (l < NL - 1 ? 384 : 0);
  unsigned* qatt = P.counters + cbase + l;
  unsigned* qscan = P.counters + cbase + 16 + l;
  if (threadIdx.x == 0) {
    const unsigned key = xb_xcc_id() * 256u + ((unsigned)__builtin_amdgcn_s_getreg((6 << 11) | (8 << 6) | 4) & 0x7Fu);
    const unsigned slot = atomicAdd(P.cucnt + key, 1u);
    int it = -1;
    if ((slot & 1u) == 0u && mode != 2) { it = (int)atomicAdd(qscan, 1u); if (it >= 256) it = -1; }
    s_item = it;
  }
  __syncthreads();
  {
    const int it = s_item;
    __syncthreads();
    if (it >= 0) scan_item(P, l, it, smem, (mode == 3) ? (8 | SCAN_PM) : 0);
  }
  for (;;) {
    if (threadIdx.x == 0) s_item = (int)atomicAdd(qatt, 1u);
    __syncthreads();
    const int item = s_item;
    __syncthreads();
    if (item >= natt) break;
    int idx = item;
    int kind, b, hh, qb; bool isctx;
    if (idx < 3072) { kind = idx >> 10; kind = (kind == 0) ? 1 : (kind == 1 ? 0 : 2); int rem = idx & 1023; b = rem >> 6; hh = (rem >> 4) & 3; qb = rem & 15; isctx = false; }
    else { idx -= 3072; kind = idx >> 7; int rem = idx & 127; b = rem >> 3; hh = (rem >> 1) & 3; qb = rem & 1; isctx = true; }
    if (kind == 0) attn_item<0>(P, l, b, hh, qb, isctx, smem);
    else if (kind == 1) attn_item<1>(P, l, b, hh, qb, isctx, smem);
    else attn_item<2>(P, l, b, hh, qb, isctx, smem);
  }
  for (;;) {
    if (threadIdx.x == 0) s_item = (int)atomicAdd(qscan, 1u);
    __syncthreads();
    const int item = s_item;
    __syncthreads();
    if (item >= 256 || mode == 2 || mode == 3) break;
    scan_item(P, l, item, smem);
  }
}

__device__ void phase_rwkv_combine(const Params& P, int l, unsigned char* smem, int bid, int nb) {
  float* sg = (float*)smem;
  const int tid = opaque_tid(), wave = tid >> 6, c = tid;
  float gup[64];
#pragma unroll
  for (int r = 0; r < 64; ++r) gup[r] = P.rwkv_g_up[((size_t)(l * 64 + r)) * 256 + c];
  const float lng = P.rwkv_ln_g[l * 256 + c], lnb = P.rwkv_ln_b[l * 256 + c], mu_v = P.rwkv_mu[l * 960 + 512 + c];
  const float mu_g = P.rwkv_mu[l * 960 + 896 + (tid & 63)];
  const bool latent_only = (l == NL - 1);
  for (int tile = bid; tile < MALL / 16; tile += nb) {
    const int m0 = tile * 16, b = m0 / TALL, t0 = m0 - b * TALL;
    const bool isctx = t0 < CTX;
    if (latent_only && isctx) continue;
    const int seglo = b * TALL + (isctx ? 0 : CTX), seghi = b * TALL + (isctx ? CTX : TALL);
#pragma unroll
    for (int i = 0; i < 4; ++i) {
      const int idx = tid + 256 * i, tok = idx >> 6, r = idx & 63;
      const int m = m0 + tok;
      const u16* pp = P.pbuf + (size_t)m * INW + 896 + r;
      const float pc = bf2f(pp[0]);
      const float pm = (m - 1 >= seglo) ? bf2f(*(pp - INW)) : 0.f;
      const float pn = (m + 1 < seghi) ? bf2f(*(pp + INW)) : 0.f;
      const float ps = pc + mu_g * (0.5f * (pm + pn) - pc);
      sg[tok * 64 + r] = 1.f / (1.f + expf(-ps));
    }
    __syncthreads();
#pragma unroll 1
    for (int tq4 = 0; tq4 < 16; tq4 += 4) {
      float ya[4], yb[4], pcv[4], pmv[4], pnv[4], csa[4], csb[4];
#pragma unroll
      for (int u = 0; u < 4; ++u) {
        const int m = m0 + tq4 + u;
        ya[u] = bf2f(P.yd[((size_t)m) * 256 + c]); yb[u] = bf2f(P.yd[((size_t)(MALL + m)) * 256 + c]);
        const u16* pv = P.pbuf + (size_t)m * INW + 512 + c;
        pcv[u] = bf2f(pv[0]);
        pmv[u] = (m - 1 >= seglo) ? bf2f(*(pv - INW)) : 0.f;
        pnv[u] = (m + 1 < seghi) ? bf2f(*(pv + INW)) : 0.f;
        csa[u] = P.cbuf[((size_t)m) * 4 + wave]; csb[u] = P.cbuf[((size_t)(MALL + m)) * 4 + wave];
      }
#pragma unroll
      for (int u = 0; u < 4; ++u) {
        const int tok = tq4 + u, m = m0 + tok;
        float gacc = 0.f;
#pragma unroll
        for (int r = 0; r < 64; r += 4) {
          const float4 s4 = *(const float4*)(sg + tok * 64 + r);
          gacc += s4.x * gup[r] + s4.y * gup[r + 1] + s4.z * gup[r + 2] + s4.w * gup[r + 3];
        }
        const float y = ya[u] + yb[u];
        const float mean = wave_sum(y) * (1.f / 64.f);
        const float dd = y - mean;
        const float var = wave_sum(dd * dd) * (1.f / 64.f);
        const float yn = dd * rsqrtf(var + 64e-5f) * lng + lnb;
        const float vs = pcv[u] + mu_v * (0.5f * (pmv[u] + pnv[u]) - pcv[u]);
        P.abuf[(size_t)m * D + c] = f2bf((yn + (csa[u] + csb[u]) * vs) * gacc);
      }
    }
    __syncthreads();
  }
}

__device__ void run_phase(const Params& P, int ph, unsigned char* smem, int bid, int nb, const XcdBarrier* xbp) {
  if (ph == 1 + 9 * NL) { phase_prep(P, NL - 1, 2, bid, nb); return; }
  const int l = (ph - 1) / 9, s = (ph - 1) - l * 9;
  const bool last = (l == NL - 1);
  switch (s) {
    case 0:
      phase_prep(P, l, 0, bid, nb);
      for (int t = bid; t < NWCONV; t += nb) wconv_tile(P, l, t, smem);
      break;
    case 1:
      phase_gemm<EPI_P, false>(P, l, P.abuf, P.w_in_t, D, INWP / 128, smem, bid, nb);
#if PROBE == 1 || PROBE == 13
      phase_gemm<EPI_P, false>(P, l, P.abuf, P.w_in_t, D, INWP / 128, smem, bid, nb);
#elif PROBE == 14
      phase_gemm<EPI_P, false>(P, l, P.abuf, P.w_in_t, D, INWP / 128, smem, bid, nb, 2);
#elif PROBE == 15
      phase_gemm<EPI_P, false>(P, l, P.abuf, P.w_in_t, D, INWP / 128, smem, bid, nb, 3);
#endif
      break;
    case 2:
      phase_attnprep(P, l, smem, bid, nb);
#if PROBE == 9
      phase_attnprep(P, l, smem, bid, nb, 1);
#endif
      break;
    case 3:
      phase_mixers(P, l, smem);
#if PROBE == 6
      xcd_barrier(*xbp);
      phase_mixers(P, l, smem, 32);
#elif PROBE == 2
      xcd_barrier(*xbp);
      phase_mixers(P, l, smem, 32, 1);
#elif PROBE == 3
      xcd_barrier(*xbp);
      phase_mixers(P, l, smem, 32, 2);
#elif PROBE == 8
      xcd_barrier(*xbp);
      phase_mixers(P, l, smem, 32, 3);
#endif
      break;
    case 4:
      phase_rwkv_combine(P, l, smem, bid, nb);
#if PROBE == 5
      phase_rwkv_combine(P, l, smem, bid, nb);
#endif
      break;
    case 5:
      if (last) phase_gemm<EPI_RES1, true>(P, l, P.abuf, P.w_out_t, D, D / 128, smem, bid, nb);
      else phase_gemm<EPI_RES1, false>(P, l, P.abuf, P.w_out_t, D, D / 128, smem, bid, nb);
#if PROBE == 11
      phase_gemm<EPI_RES1, false>(P, l, P.abuf, P.w_out_t, D, D / 128, smem, bid, nb, 1);
#endif
      break;
    case 6:
      phase_prep(P, l, 1, bid, nb);
#if PROBE == 10
      phase_prep(P, l, 1, bid, nb, 1);
#endif
      break;
    case 7:
      if (last) phase_gemm<EPI_SWIGLU, true>(P, l, P.abuf, P.ffn_in_t, D, (2 * DFF) / 128, smem, bid, nb);
      else phase_gemm<EPI_SWIGLU, false>(P, l, P.abuf, P.ffn_in_t, D, (2 * DFF) / 128, smem, bid, nb);
#if PROBE == 1
      phase_gemm<EPI_SWIGLU, false>(P, l, P.abuf, P.ffn_in_t, D, (2 * DFF) / 128, smem, bid, nb);
#endif
      break;
    case 8:
      if (last) phase_gemm<EPI_RES2, true>(P, l, P.pbuf, P.ffn_out_t, DFF, D / 128, smem, bid, nb);
      else phase_gemm<EPI_RES2, false>(P, l, P.pbuf, P.ffn_out_t, DFF, D / 128, smem, bid, nb);
#if PROBE == 12
      phase_gemm<EPI_RES2, false>(P, l, P.pbuf, P.ffn_out_t, DFF, D / 128, smem, bid, nb, 1);
#elif PROBE == 16
      phase_gemm<EPI_RES2, false>(P, l, P.pbuf, P.ffn_out_t, DFF, D / 128, smem, bid, nb, 3);
#endif
      break;
  }
}

__global__ void __launch_bounds__(256, 2) fwd_megakernel(Params P, int ph_begin, int ph_end) {
  __shared__ __attribute__((aligned(16))) unsigned char smem[SMEM_BYTES];
  __shared__ uint4 xb_words;
  cg::grid_group grid = cg::this_grid();
  const int bid = blockIdx.x, nb = gridDim.x;
  if (threadIdx.x == 0) xb_words = make_uint4(0u, 0u, 0u, 0u);
  __syncthreads();
  (void)xcd_barrier_post(P.bar, (volatile LAS unsigned*)&xb_words);
  phase0(P, smem, bid, nb);
#if PROBE == 17
  phase0(P, smem, bid, nb);
#endif
  if (ph_end < 0) grid.sync();
  {
    XcdBarrier xb0; xb0.bar = P.bar; xb0.x = xb_xcc_id(); xb0.st = (volatile LAS unsigned*)&xb_words;
    xcd_barrier(xb0);
  }
  for (int ph = ph_begin + 1; ph < ph_end; ++ph) {
    XcdBarrier xb; xb.bar = P.bar; xb.x = xb_xcc_id(); xb.st = (volatile LAS unsigned*)&xb_words;
    run_phase(P, ph, smem, bid, nb, &xb);
    if (ph + 1 < ph_end) xcd_barrier(xb);
#if PROBE == 4
    xcd_barrier(xb); xcd_barrier(xb);
#endif
  }
}

extern "C" void kernel_launch(void* const* d_in, const int* in_sizes, int n_in, void* d_out, int out_size, void* d_ws,
                              size_t ws_size, hipStream_t stream) {
  Params P{};
  const float** pp = (const float**)&P;
  for (int i = 0; i < 29; ++i) pp[i] = (const float*)d_in[i];
  P.out = (float*)d_out;
  char* ws = (char*)d_ws;
  size_t off = 0;
  auto take = [&](size_t bytes) { char* p = ws + off; off += (bytes + 255) & ~(size_t)255; return p; };
  P.counters = (unsigned*)take(256);
  P.bar = (unsigned*)take(XCD_BAR_WORDS * 4);
  P.cucnt = (unsigned*)take(4096 * 4);
  P.lamv = (float*)take(256);
  P.mod = (float*)take((size_t)NL * 17 * 6144 * 4);
  P.ropeA = (float*)take(64 * 16 * 2 * 4);
  P.ropeD = (float*)take(64 * 8 * 2 * 4);
  P.ropeR = (float*)take(2048 * 32 * 2 * 4);
  P.cbuf = (float*)take((size_t)2 * MALL * 4 * 4);
  P.w_in_t = (u16*)take((size_t)INWP * D * 2);
  P.w_out_t = (u16*)take((size_t)D * D * 2);
  P.ffn_in_t = (u16*)take((size_t)2 * DFF * D * 2);
  P.ffn_out_t = (u16*)take((size_t)D * DFF * 2);
  P.zctx = (float*)take((size_t)NBATCH * CTX * D * 4);
  P.pbuf = (u16*)take((size_t)MALL * INW * 2);
  P.abuf = (u16*)take((size_t)MALL * D * 2);
  P.yd = (u16*)take((size_t)2 * MALL * 256 * 2);
  P.vt = (u16*)take((size_t)NBATCH * 10 * 64 * TALL * 2);
  P.stats = (float*)take((size_t)MALL * 2 * 4);
  if (off > ws_size) fprintf(stderr, "workspace too small: need %zu have %zu\n", off, ws_size);

  static int grid_blocks = 0;
  if (!grid_blocks) {
    int dev = 0, cus = 0, per_cu = 0;
    (void)hipGetDevice(&dev);
    (void)hipDeviceGetAttribute(&cus, hipDeviceAttributeMultiprocessorCount, dev);
    (void)hipOccupancyMaxActiveBlocksPerMultiprocessor(&per_cu, fwd_megakernel, 256, 0);
    if (per_cu > 2) per_cu = 2;
    if (per_cu < 1) per_cu = 1;
    grid_blocks = cus * per_cu;
  }
  (void)hipMemsetAsync(P.counters, 0, 256 + XCD_BAR_WORDS * 4 + 4096 * 4, stream);
  int ph_begin = 0, ph_end = 2 + 9 * NL;
  void* args[] = {&P, &ph_begin, &ph_end};
  hipError_t e = hipLaunchCooperativeKernel((void*)fwd_megakernel, dim3(grid_blocks), dim3(256), args, 0, stream);
  if (e != hipSuccess) fprintf(stderr, "cooperative launch failed: %s (grid %d)\n", hipGetErrorString(e), grid_blocks);
}
```

```cpp
#include <hip/hip_runtime.h>
#include <hip/hip_cooperative_groups.h>
#include <cstdio>
#ifndef PROBE
#define PROBE 0
#endif
#ifndef SCAN_PM
#define SCAN_PM 0
#endif
namespace cg = cooperative_groups;

typedef unsigned short u16;
using bf16x8 = __attribute__((ext_vector_type(8))) short;
using f32x16 = __attribute__((ext_vector_type(16))) float;
using u32x4 = __attribute__((ext_vector_type(4))) unsigned;
#define DI __device__ __forceinline__
#define MFMA32(a, b, c) __builtin_amdgcn_mfma_f32_32x32x16_bf16((a), (b), (c), 0, 0, 0)

static constexpr int D = 1024, NBATCH = 16, SEQ = 2048, CTX = 256, TALL = 2304, MALL = 36864, NL = 4;
static constexpr int INW = 3264, INWP = 3328, DFF = 2816;
static constexpr float ALPHA = 1.681792830507429f;
static constexpr float LOG2E = 1.4426950408889634f;
static constexpr int SMEM_BYTES = 79872;
static constexpr int NWCONV = 3200;

struct Params {
  const float *x, *c, *ctx, *c_ctx, *ada_w, *ada_b, *w_in, *rwkv_mu, *rwkv_w0, *rwkv_w_up, *rwkv_a0, *rwkv_a_up,
      *rwkv_g_up, *rwkv_k_k, *rwkv_k_a, *rwkv_r_k, *rwkv_ln_g, *rwkv_ln_b, *gqa_q_norm, *gqa_k_norm, *diff_lambda,
      *diff_norm, *w_out, *post1_g, *post1_b, *ffn_w_in, *ffn_w_out, *post2_g, *post2_b;
  float* out;
  unsigned* counters;
  unsigned* bar;
  unsigned* cucnt;
  float *lamv, *mod, *ropeA, *ropeD, *ropeR, *cbuf;
  u16 *w_in_t, *w_out_t, *ffn_in_t, *ffn_out_t;
  float* zctx;
  u16 *pbuf, *abuf;
  u16* yd;
  u16* vt;
  float* stats;
};

DI u16 f2bf(float x) { unsigned u = __float_as_uint(x); u += 0x7fffu + ((u >> 16) & 1u); return (u16)(u >> 16); }
DI float bf2f(u16 v) { return __uint_as_float(((unsigned)v) << 16); }
typedef __bf16 bf16v2 __attribute__((ext_vector_type(2)));
typedef float f32v2 __attribute__((ext_vector_type(2)));
DI unsigned pack2(float a, float b) { f32v2 v = {a, b}; bf16v2 r = __builtin_convertvector(v, bf16v2); return __builtin_bit_cast(unsigned, r); }
DI int opaque_tid() { int t = threadIdx.x; asm volatile("" : "+v"(t)); return t; }
DI int crow(int i, int h) { return (i & 3) + 8 * (i >> 2) + 4 * h; }
DI float dpp_f(float x, const int ctrl_sel) {
  int v = __float_as_int(x), r;
  if (ctrl_sel == 0) r = __builtin_amdgcn_update_dpp(0, v, 0xB1, 0xF, 0xF, true);
  else if (ctrl_sel == 1) r = __builtin_amdgcn_update_dpp(0, v, 0x4E, 0xF, 0xF, true);
  else r = __builtin_amdgcn_update_dpp(0, v, 0x141, 0xF, 0xF, true);
  return __int_as_float(r);
}
DI float xhalf_max(float x) {
  const auto r_ = __builtin_amdgcn_permlane32_swap(__float_as_uint(x), __float_as_uint(x), false, false);
  return fmaxf(__uint_as_float(r_[0]), __uint_as_float(r_[1]));
}
DI float xhalf_sum(float x) {
  const auto r_ = __builtin_amdgcn_permlane32_swap(__float_as_uint(x), __float_as_uint(x), false, false);
  return __uint_as_float(r_[0]) + __uint_as_float(r_[1]);
}
DI float reduce8(float x) { x += dpp_f(x, 0); x += dpp_f(x, 1); x += dpp_f(x, 2); return x; }
DI float wave_sum(float x) {
  x += dpp_f(x, 0); x += dpp_f(x, 1); x += dpp_f(x, 2);
  x += __int_as_float(__builtin_amdgcn_update_dpp(0, __float_as_int(x), 0x140, 0xF, 0xF, true));
  const int xi = __float_as_int(x);
  const float a = __int_as_float(__builtin_amdgcn_readlane(xi, 0)), b = __int_as_float(__builtin_amdgcn_readlane(xi, 16));
  const float c = __int_as_float(__builtin_amdgcn_readlane(xi, 32)), d = __int_as_float(__builtin_amdgcn_readlane(xi, 48));
  return (a + b) + (c + d);
}
DI float* xrow_ptr(const Params& P, int m) {
  int b = m / TALL, t = m - b * TALL;
  return t < CTX ? P.zctx + ((size_t)(b * CTX + t)) * D : P.out + ((size_t)(b * SEQ + t - CTX)) * D;
}


#define XB_TMO      128
#define XB_XCNT(j)  (256  + 64 * (j))
#define XB_XSUB(j)  (1280 + 64 * (j))
#define XB_XGEN(j)  (2304 + 64 * (j))
#define XB_TOP      3328
#define XB_TOPGEN   3392
#define XCD_BAR_WORDS 3456
#define XB_SPIN_CAP (1u << 20)
#define LAS __attribute__((address_space(3)))
DI unsigned xb_ld(unsigned* p) { return __hip_atomic_load(p, __ATOMIC_RELAXED, __HIP_MEMORY_SCOPE_AGENT); }
DI unsigned xb_add(unsigned* p, unsigned v) { return __hip_atomic_fetch_add(p, v, __ATOMIC_RELAXED, __HIP_MEMORY_SCOPE_AGENT); }
DI unsigned xb_xcc_id() { return (unsigned)__builtin_amdgcn_s_getreg((3 << 11) | 20) & 0xFu; }
#define XB_SPIN(cond, bar) do { unsigned _sp = 0; while (cond) { __builtin_amdgcn_s_sleep(1); \
    if ((++_sp & 255u) == 0u) { if (xb_ld(&(bar)[XB_TMO])) break; if (_sp > XB_SPIN_CAP) { atomicAdd(&(bar)[XB_TMO], 1u); break; } } } } while (0)
struct XcdBarrier { unsigned* bar; unsigned x; volatile LAS unsigned* st; };
DI XcdBarrier xcd_barrier_post(unsigned* bar, volatile LAS unsigned* st) {
  XcdBarrier b; b.bar = bar; b.x = xb_xcc_id(); b.st = st;
  if (threadIdx.x == 0) (void)xb_add(&bar[XB_XCNT(b.x)], 1u);
  return b;
}
DI void xcd_barrier_complete(unsigned* bar, unsigned x, unsigned& nloc, unsigned& nx) {
  const unsigned G = gridDim.x * gridDim.y * gridDim.z;
  unsigned sum, cnt, mine, sp = 0u;
  for (;;) {
    sum = 0u; cnt = 0u; mine = 0u;
#pragma unroll
    for (unsigned j = 0; j < 16; ++j) { const unsigned c = xb_ld(&bar[XB_XCNT(j)]); sum += c; cnt += (c > 0u) ? 1u : 0u; mine = (j == x) ? c : mine; }
    if (sum == G) break;
    __builtin_amdgcn_s_sleep(1);
    if ((++sp & 255u) == 0u) { if (xb_ld(&bar[XB_TMO])) break; if (sp > XB_SPIN_CAP) { atomicAdd(&bar[XB_TMO], 1u); break; } }
  }
  nloc = mine > 0u ? mine : 1u; nx = cnt > 0u ? cnt : 1u;
}
DI void xcd_barrier(const XcdBarrier& b) {
  asm volatile("s_waitcnt vmcnt(0)" ::: "memory");
  __syncthreads();
  if (threadIdx.x == 0) {
    unsigned* bar = b.bar;
    __builtin_amdgcn_s_waitcnt(0);
    unsigned nloc = b.st[0], nx = b.st[1];
    if (nloc == 0u) { xcd_barrier_complete(bar, b.x, nloc, nx); b.st[0] = nloc; b.st[1] = nx; }
    const unsigned old = xb_add(&bar[XB_XSUB(b.x)], 1u);
    const unsigned gen = old / nloc;
    if (old + 1u == (gen + 1u) * nloc) {
      __builtin_amdgcn_fence(__ATOMIC_RELEASE, "agent");
      asm volatile("s_waitcnt vmcnt(0)" ::: "memory");
      const unsigned og = xb_add(&bar[XB_TOP], 1u);
      const unsigned tg = og / nx;
      if (og + 1u == (tg + 1u) * nx) xb_add(&bar[XB_TOPGEN], 1u);
      else XB_SPIN(xb_ld(&bar[XB_TOPGEN]) == tg, bar);
      __builtin_amdgcn_fence(__ATOMIC_ACQUIRE, "agent");
      xb_add(&bar[XB_XGEN(b.x)], 1u);
      asm volatile("s_waitcnt vmcnt(0)" ::: "memory");
    } else {
      XB_SPIN(xb_ld(&bar[XB_XGEN(b.x)]) == gen, bar);
      __builtin_amdgcn_fence(__ATOMIC_ACQUIRE, "agent");
      asm volatile("s_waitcnt vmcnt(0)" ::: "memory");
    }
  }
  __syncthreads();
}

__device__ void wconv_tile(const Params& P, int l, int tile, unsigned char* smem) {
  float* T = (float*)smem;
  const int tid = opaque_tid();
  const float* src; u16* dst; int ldN, ldK, k0, n0; int kind;
  if (tile < 832) { kind = 0; int nt = tile >> 4, kt = tile & 15; src = P.w_in + (size_t)l * D * INW; ldN = INW; dst = P.w_in_t; ldK = D; k0 = kt * 64; n0 = nt * 64; }
  else if (tile < 1088) { kind = 1; int t = tile - 832; int nt = t >> 4, kt = t & 15; src = P.w_out + (size_t)l * D * D; ldN = D; dst = P.w_out_t; ldK = D; k0 = kt * 64; n0 = nt * 64; }
  else if (tile < 2496) { kind = 2; int t = tile - 1088; int nt = t >> 4, kt = t & 15; src = P.ffn_w_in + (size_t)l * D * (2 * DFF); ldN = 2 * DFF; dst = P.ffn_in_t; ldK = D; k0 = kt * 64; n0 = nt * 64; }
  else { kind = 3; int t = tile - 2496; int nt = t / 44, kt = t - nt * 44; src = P.ffn_w_out + (size_t)l * DFF * D; ldN = D; dst = P.ffn_out_t; ldK = DFF; k0 = kt * 64; n0 = nt * 64; }
  const int j = tid & 63, g = tid >> 6;
  int scol;
  bool zero = false;
  if (kind == 2) { int blk = n0 >> 7, w = (n0 >> 6) & 1; int hb = blk * 64 + w * 32; scol = (j < 32) ? hb + j : DFF + hb + (j - 32); }
  else { scol = n0 + j; if (kind == 0 && scol >= INW) zero = true; }
#pragma unroll 4
  for (int i = 0; i < 16; ++i) {
    int kr = g + 4 * i;
    T[kr * 65 + j] = zero ? 0.f : src[(size_t)(k0 + kr) * ldN + scol];
  }
  __syncthreads();
#pragma unroll 4
  for (int i = 0; i < 16; ++i) {
    int jr = g + 4 * i;
    dst[(size_t)(n0 + jr) * ldK + k0 + j] = f2bf(T[j * 65 + jr]);
  }
  __syncthreads();
}

__device__ void phase0(const Params& P, unsigned char* smem, int bid, int nb) {
  const int tid = opaque_tid();
  const int total = 384 + 256 + 1;
  for (int item = bid; item < total; item += nb) {
    if (item < 384) {
      const int l = item / 96, col0 = (item - l * 96) * 64;
      float* sc = (float*)smem;
      for (int i = tid; i < 17 * 1024; i += 256) {
        int r = i >> 10, k = i & 1023;
        float v = r < 16 ? P.c[r * 1024 + k] : P.c_ctx[k];
        sc[i] = v / (1.f + expf(-v));
      }
      __syncthreads();
      const int col = tid & 63, kq = tid >> 6;
      float acc[17];
#pragma unroll
      for (int r = 0; r < 17; ++r) acc[r] = 0.f;
      const float* w = P.ada_w + ((size_t)l * 1024 + kq * 256) * 6144 + col0 + col;
#pragma unroll 2
      for (int k = 0; k < 256; k += 4) {
        float w0 = w[(size_t)(k + 0) * 6144], w1 = w[(size_t)(k + 1) * 6144], w2 = w[(size_t)(k + 2) * 6144], w3 = w[(size_t)(k + 3) * 6144];
#pragma unroll
        for (int r = 0; r < 17; ++r) {
          float4 s = *(const float4*)(sc + r * 1024 + kq * 256 + k);
          acc[r] += s.x * w0 + s.y * w1 + s.z * w2 + s.w * w3;
        }
      }
      __syncthreads();
      float* red = (float*)smem;
#pragma unroll
      for (int r = 0; r < 17; ++r) red[(kq * 17 + r) * 64 + col] = acc[r];
      __syncthreads();
      for (int i = tid; i < 17 * 64; i += 256) {
        int r = i >> 6, cc = i & 63;
        float s = red[(0 * 17 + r) * 64 + cc] + red[(1 * 17 + r) * 64 + cc] + red[(2 * 17 + r) * 64 + cc] + red[(3 * 17 + r) * 64 + cc];
        P.mod[((size_t)(l * 17 + r)) * 6144 + col0 + cc] = s + P.ada_b[l * 6144 + col0 + cc];
      }
      __syncthreads();
    } else if (item < 384 + 256) {
      int e = (item - 384) * 256 + tid;
      int pos = e >> 5, i = e & 31;
      double inv = pow(10000.0, -2.0 * (double)i / 64.0);
      double ang = (double)pos * inv;
      P.ropeR[e * 2] = (float)cos(ang);
      P.ropeR[e * 2 + 1] = (float)sin(ang);
    } else {
      for (int e = tid; e < 64 * 16; e += 256) {
        int pos = e >> 4, i = e & 15;
        double ang = (double)pos * pow(10000.0, -2.0 * (double)i / 32.0);
        P.ropeA[e * 2] = (float)cos(ang); P.ropeA[e * 2 + 1] = (float)sin(ang);
      }
      for (int e = tid; e < 64 * 8; e += 256) {
        int pos = e >> 3, i = e & 7;
        double ang = (double)pos * pow(10000.0, -2.0 * (double)i / 16.0);
        P.ropeD[e * 2] = (float)cos(ang); P.ropeD[e * 2 + 1] = (float)sin(ang);
      }
      if (tid < NL) {
        const float* dl = P.diff_lambda + tid * 128;
        float s1 = 0.f, s2 = 0.f;
        for (int i = 0; i < 32; ++i) { s1 += dl[i] * dl[32 + i]; s2 += dl[64 + i] * dl[96 + i]; }
        float li = (float)(0.8 - 0.6 * exp(-0.3 * (double)tid));
        P.lamv[tid * 2] = expf(s1) - expf(s2) + li;
        P.lamv[tid * 2 + 1] = li;
      }
    }
  }
}

__device__ void phase_prep(const Params& P, int l, int mode, int bid, int nb, const int dummy = 0) {
  const int tid = opaque_tid();
  const int lane = tid & 63, wave = tid >> 6;
  const bool latent_only = (mode == 2) || (mode == 1 && l == NL - 1);
  const bool do_ln = !(mode == 0 && l == 0);
  const float* lg = P.post1_g; const float* lb = P.post1_b;
  if (mode == 0) { if (l > 0) { lg = P.post2_g + (l - 1) * D; lb = P.post2_b + (l - 1) * D; } }
  else if (mode == 1) { lg = P.post1_g + l * D; lb = P.post1_b + l * D; }
  else { lg = P.post2_g + (NL - 1) * D; lb = P.post2_b + (NL - 1) * D; }
  const int shofs = (mode == 0) ? 0 : 3 * D, scofs = shofs + D;
  const int mstep = nb * 4;
  int mn = bid * 4 + wave;
  while (mn < MALL && latent_only && (mn % TALL) < CTX) mn += mstep;
  float4 nv0 = make_float4(0.f, 0.f, 0.f, 0.f), nv1 = nv0, nv2 = nv0, nv3 = nv0;
  if (mn < MALL) {
    const int b = mn / TALL, t = mn - b * TALL; const bool isctx = t < CTX;
    const float* src = do_ln ? (isctx ? P.zctx + ((size_t)(b * CTX + t)) * D : P.out + ((size_t)(b * SEQ + t - CTX)) * D)
                             : (isctx ? P.ctx + ((size_t)(b * CTX + t)) * D : P.x + ((size_t)(b * SEQ + t - CTX)) * D);
    nv0 = *(const float4*)(src + lane * 4); nv1 = *(const float4*)(src + 256 + lane * 4); nv2 = *(const float4*)(src + 512 + lane * 4); nv3 = *(const float4*)(src + 768 + lane * 4);
  }
  while (mn < MALL) {
    const int m = mn;
    const int b = m / TALL, t = m - b * TALL;
    const bool isctx = t < CTX;
    float* xr = isctx ? P.zctx + ((size_t)(b * CTX + t)) * D : P.out + ((size_t)(b * SEQ + t - CTX)) * D;
    float4 v[4];
    v[0] = nv0; v[1] = nv1; v[2] = nv2; v[3] = nv3;
    mn += mstep;
    while (mn < MALL && latent_only && (mn % TALL) < CTX) mn += mstep;
    if (mn < MALL) {
      const int b2 = mn / TALL, t2 = mn - b2 * TALL; const bool c2 = t2 < CTX;
      const float* src = do_ln ? (c2 ? P.zctx + ((size_t)(b2 * CTX + t2)) * D : P.out + ((size_t)(b2 * SEQ + t2 - CTX)) * D)
                               : (c2 ? P.ctx + ((size_t)(b2 * CTX + t2)) * D : P.x + ((size_t)(b2 * SEQ + t2 - CTX)) * D);
      nv0 = *(const float4*)(src + lane * 4); nv1 = *(const float4*)(src + 256 + lane * 4); nv2 = *(const float4*)(src + 512 + lane * 4); nv3 = *(const float4*)(src + 768 + lane * 4);
    }
    float4 v0s[4];
    if (dummy) {
#pragma unroll
      for (int i = 0; i < 4; ++i) v0s[i] = v[i];
    }
    if (do_ln) {
      float s = 0.f;
#pragma unroll
      for (int i = 0; i < 4; ++i) s += v[i].x + v[i].y + v[i].z + v[i].w;
      const float mean = wave_sum(s) * (1.f / 1024.f);
      float q = 0.f;
#pragma unroll
      for (int i = 0; i < 4; ++i) { v[i].x -= mean; v[i].y -= mean; v[i].z -= mean; v[i].w -= mean; q += v[i].x * v[i].x + v[i].y * v[i].y + v[i].z * v[i].z + v[i].w * v[i].w; }
      const float rstd = rsqrtf(wave_sum(q) * (1.f / 1024.f) + 1e-5f);
      if (mode != 2 && lane == 0) *(float2*)(P.stats + (size_t)m * 2) = make_float2(mean, rstd);
#pragma unroll
      for (int i = 0; i < 4; ++i) {
        float4 g4 = *(const float4*)(lg + i * 256 + lane * 4), b4 = *(const float4*)(lb + i * 256 + lane * 4);
        v[i].x = v[i].x * rstd * g4.x + b4.x; v[i].y = v[i].y * rstd * g4.y + b4.y; v[i].z = v[i].z * rstd * g4.z + b4.z; v[i].w = v[i].w * rstd * g4.w + b4.w;
      }
    }
    if (dummy) {
#pragma unroll
      for (int i = 0; i < 4; ++i) { asm volatile("" :: "v"(v[i].x), "v"(v[i].y), "v"(v[i].z), "v"(v[i].w)); v[i] = v0s[i]; }
    }
    if (mode == 2 || dummy) {
#pragma unroll
      for (int i = 0; i < 4; ++i) *(float4*)(xr + i * 256 + lane * 4) = v[i];
    }
    if (mode != 2) {
      const int modrow = isctx ? 16 : b;
      const float* md = P.mod + ((size_t)(l * 17 + modrow)) * 6144;
#pragma unroll
      for (int i = 0; i < 4; ++i) {
        float4 sh = *(const float4*)(md + shofs + i * 256 + lane * 4), sc = *(const float4*)(md + scofs + i * 256 + lane * 4);
        uint2 o;
        o.x = pack2(v[i].x * (1.f + sc.x) + sh.x, v[i].y * (1.f + sc.y) + sh.y);
        o.y = pack2(v[i].z * (1.f + sc.z) + sh.z, v[i].w * (1.f + sc.w) + sh.w);
        *(uint2*)(P.abuf + (size_t)m * D + i * 256 + lane * 4) = o;
      }
    }
  }
}

enum { EPI_P = 0, EPI_RES1 = 1, EPI_RES2 = 2, EPI_SWIGLU = 3 };
template <int EPI, bool latent_only>
__device__ void phase_gemm(const Params& P, int l, const u16* __restrict__ A, const u16* __restrict__ Bt, const int K,
                           const int NT, unsigned char* smem, int bid, int nb, const int dummy = 0) {
  u16* sA = (u16*)smem;
  u16* sB = sA + 2 * 128 * 72;
  const int tid = opaque_tid(), lane = tid & 63, wave = tid >> 6, r = lane & 31, h = lane >> 5, wm = wave >> 1, wn = wave & 1;
  const int MT = latent_only ? 256 : 288;
  const int total = MT * NT, KT = K >> 6;
  const int lrow = tid >> 3, lkc = tid & 7;
  const bool swz = ((nb & 7) == 0);
  const int qstart = swz ? (bid >> 3) : bid, qstep = swz ? (nb >> 3) : nb, qtotal = swz ? (MT >> 3) * NT : total;
  for (int q = qstart; q < qtotal; q += qstep) {
    int mq, nt;
    if (swz) {
      const int MTX = MT >> 3, per_sr = 8 * NT;
      const int sr = q / per_sr, rem = q - sr * per_sr;
      const int gm = min(8, MTX - sr * 8);
      nt = rem / gm; mq = sr * 8 + (rem - nt * gm);
    } else { mq = q / NT; nt = q - mq * NT; }
    const int mi_ = swz ? (mq * 8 + (bid & 7)) : mq;
    const int mt = latent_only ? ((mi_ >> 4) * 18 + 2 + (mi_ & 15)) : mi_;
    const int m0 = mt * 128, n0 = nt * 128;
    f32x16 acc[2][2];
#pragma unroll
    for (int a = 0; a < 2; ++a)
#pragma unroll
      for (int b = 0; b < 2; ++b)
#pragma unroll
        for (int i = 0; i < 16; ++i) acc[a][b][i] = 0.f;
    const u16* Ag = A + (size_t)(m0 + lrow) * K + lkc * 8;
    const u16* Bg = Bt + (size_t)(n0 + lrow) * K + lkc * 8;
    const size_t K32 = (size_t)32 * K;
    uint4 xa0, xa1, xa2, xa3, xb0, xb1, xb2, xb3;
    uint4 ya0, ya1, ya2, ya3, yb0, yb1, yb2, yb3;
#define G_LOAD(S, kt_) { const int ko_ = (kt_) * 64; \
      S##a0 = *(const uint4*)(Ag + ko_); S##a1 = *(const uint4*)(Ag + K32 + ko_); S##a2 = *(const uint4*)(Ag + 2 * K32 + ko_); S##a3 = *(const uint4*)(Ag + 3 * K32 + ko_); \
      S##b0 = *(const uint4*)(Bg + ko_); S##b1 = *(const uint4*)(Bg + K32 + ko_); S##b2 = *(const uint4*)(Bg + 2 * K32 + ko_); S##b3 = *(const uint4*)(Bg + 3 * K32 + ko_); }
#define G_STORE(S, st_) { u16* sa_ = sA + (st_) * (128 * 72) + lrow * 72 + lkc * 8; u16* sb_ = sB + (st_) * (128 * 72) + lrow * 72 + lkc * 8; \
      *(uint4*)(sa_) = S##a0; *(uint4*)(sa_ + 32 * 72) = S##a1; *(uint4*)(sa_ + 64 * 72) = S##a2; *(uint4*)(sa_ + 96 * 72) = S##a3; \
      *(uint4*)(sb_) = S##b0; *(uint4*)(sb_ + 32 * 72) = S##b1; *(uint4*)(sb_ + 64 * 72) = S##b2; *(uint4*)(sb_ + 96 * 72) = S##b3; }
#define G_COMPUTE(st_) { \
      const u16* a_ = sA + (st_) * (128 * 72) + (wm * 64 + r) * 72 + h * 8; \
      const u16* b_ = sB + (st_) * (128 * 72) + (wn * 64 + r) * 72 + h * 8; \
      __builtin_amdgcn_s_setprio(1); \
      _Pragma("unroll") for (int ks = 0; ks < 4; ++ks) { \
        bf16x8 a0 = *(const bf16x8*)(a_ + ks * 16), a1 = *(const bf16x8*)(a_ + 32 * 72 + ks * 16); \
        bf16x8 b0 = *(const bf16x8*)(b_ + ks * 16), b1 = *(const bf16x8*)(b_ + 32 * 72 + ks * 16); \
        acc[0][0] = MFMA32(a0, b0, acc[0][0]); acc[0][1] = MFMA32(a0, b1, acc[0][1]); \
        acc[1][0] = MFMA32(a1, b0, acc[1][0]); acc[1][1] = MFMA32(a1, b1, acc[1][1]); } \
      __builtin_amdgcn_s_setprio(0); }
    G_LOAD(x, 0);
    G_STORE(x, 0);
    __syncthreads();
    if (KT > 1) G_LOAD(x, 1);
    for (int kt = 0; kt < KT; kt += 2) {
      if (kt + 2 < KT && dummy != 2) G_LOAD(y, kt + 2);
      G_COMPUTE(0);
      if (kt + 1 < KT && dummy != 2) G_STORE(x, 1);
      __syncthreads();
      if (kt + 1 >= KT) break;
      if (kt + 3 < KT && dummy != 2) G_LOAD(x, kt + 3);
      G_COMPUTE(1);
      if (kt + 2 < KT && dummy != 2) G_STORE(y, 0);
      __syncthreads();
    }
#undef G_LOAD
#undef G_STORE
#undef G_COMPUTE
    int m0e = m0, n0e = n0;
    asm volatile("" : "+s"(m0e), "+s"(n0e));
    int rb = wm * 64 + 4 * h, cb = wn * 64 + r;
    asm volatile("" : "+v"(rb), "+v"(cb));
    if (EPI == EPI_P) {
      const int wc0 = n0e + (cb & 64);
      int vh = -1;
      if (wc0 >= 1344 && wc0 < 1472) vh = (wc0 - 1344) >> 6;
      else if (wc0 >= 1984 && wc0 < 2240) vh = 2 + ((wc0 - 1984) >> 6);
      else if (wc0 >= 2752 && wc0 < 3008) vh = 6 + ((wc0 - 2752) >> 6);
      if (vh >= 0) {
        const int bb = m0e / TALL, t0 = m0e - bb * TALL;
#pragma unroll
        for (int mi = 0; mi < 2; ++mi)
#pragma unroll
          for (int ni = 0; ni < 2; ++ni)
#pragma unroll
            for (int g4 = 0; g4 < 4; ++g4) {
              const int d = ni * 32 + (cb & 31);
              const int tkn = t0 + (rb & 64) + mi * 32 + 8 * g4 + (rb & 63);
              const int q4 = (tkn >> 2) & 3;
              const int tk = (tkn & ~15) | ((q4 == 1 ? 2 : (q4 == 2 ? 1 : q4)) << 2);
              uint2 w;
              w.x = pack2(acc[mi][ni][4 * g4], acc[mi][ni][4 * g4 + 1]);
              w.y = pack2(acc[mi][ni][4 * g4 + 2], acc[mi][ni][4 * g4 + 3]);
              *(uint2*)(P.vt + ((size_t)((bb * 10 + vh) * 64 + d)) * TALL + tk) = w;
            }
      } else
#pragma unroll
      for (int mi = 0; mi < 2; ++mi)
#pragma unroll
        for (int ni = 0; ni < 2; ++ni) {
          const int col = n0e + cb + ni * 32;
          if (col < INW && (dummy < 2 || acc[mi][ni][0] == 12345.678f)) {
            const bool odd = (cb & 1) != 0;
#pragma unroll
            for (int i = 0; i < 16; i += 2) {
              const float a = acc[mi][ni][i], b2 = acc[mi][ni][i + 1];
              const float recv = dpp_f(odd ? a : b2, 0);
              const int row = m0e + rb + mi * 32 + (i & 3) + 8 * (i >> 2) + (odd ? 1 : 0);
              const unsigned w = odd ? pack2(recv, b2) : pack2(a, recv);
              __builtin_nontemporal_store(w, (unsigned*)(P.pbuf + (size_t)row * INW + (col & ~1)));
            }
          }
        }
    } else if (EPI == EPI_RES1 || EPI == EPI_RES2) {
      const int b = m0e / TALL, t0 = m0e - b * TALL;
      const bool isctx = t0 < CTX;
      float* xb = isctx ? P.zctx + ((size_t)(b * CTX + t0)) * D : P.out + ((size_t)(b * SEQ + t0 - CTX)) * D;
      const float* g = P.mod + ((size_t)(l * 17 + (isctx ? 16 : b))) * 6144 + (EPI == EPI_RES1 ? 2 * D : 5 * D);
      const float* xs = (EPI == EPI_RES1 && l == 0) ? (isctx ? P.ctx + ((size_t)(b * CTX + t0)) * D : P.x + ((size_t)(b * SEQ + t0 - CTX)) * D) : xb;
      const float gv0 = g[n0e + cb], gv1 = g[n0e + cb + 32];
      const bool haveln = !(EPI == EPI_RES1 && l == 0);
      const float* lgp = (EPI == EPI_RES1) ? P.post2_g + (size_t)(l > 0 ? l - 1 : 0) * D : P.post1_g + (size_t)l * D;
      const float* lbp = (EPI == EPI_RES1) ? P.post2_b + (size_t)(l > 0 ? l - 1 : 0) * D : P.post1_b + (size_t)l * D;
      const float lg0 = lgp[n0e + cb], lg1 = lgp[n0e + cb + 32], lb0 = lbp[n0e + cb], lb1 = lbp[n0e + cb + 32];
#pragma unroll
      for (int mi = 0; mi < 2; ++mi) {
        float xo[2][16];
        float2 ms[16];
#pragma unroll
        for (int ni = 0; ni < 2; ++ni)
#pragma unroll
          for (int i = 0; i < 16; ++i)
            xo[ni][i] = xs[(size_t)(rb + mi * 32 + (i & 3) + 8 * (i >> 2)) * D + n0e + cb + ni * 32];
#pragma unroll
        for (int i = 0; i < 16; ++i)
          ms[i] = haveln ? *(const float2*)(P.stats + (size_t)(m0e + rb + mi * 32 + (i & 3) + 8 * (i >> 2)) * 2) : make_float2(0.f, 1.f);
        if (haveln) {
#pragma unroll
          for (int ni = 0; ni < 2; ++ni)
#pragma unroll
            for (int i = 0; i < 16; ++i) xo[ni][i] = (xo[ni][i] - ms[i].x) * ms[i].y * (ni ? lg1 : lg0) + (ni ? lb1 : lb0);
        }
#pragma unroll
        for (int ni = 0; ni < 2; ++ni)
#pragma unroll
          for (int i = 0; i < 16; ++i) {
            float* px = xb + (size_t)(rb + mi * 32 + (i & 3) + 8 * (i >> 2)) * D + n0e + cb + ni * 32;
            if (dummy == 3) { if (acc[mi][ni][i] == 12345.678f) *px = 0.f; }
            else {
              float xn = ALPHA * xo[ni][i] + (ni ? gv1 : gv0) * acc[mi][ni][i];
              if (dummy) { asm volatile("" :: "v"(xn)); xn = xo[ni][i]; }
              *px = xn;
            }
          }
      }
    } else {
      const int hb = (n0e >> 7) * 64 + (cb >> 6) * 32 + (cb & 31);
      const bool odd = (cb & 1) != 0;
#pragma unroll
      for (int mi = 0; mi < 2; ++mi)
#pragma unroll
        for (int i = 0; i < 16; i += 2) {
          const float u0 = acc[mi][0][i], g0 = acc[mi][1][i], u1 = acc[mi][0][i + 1], g1 = acc[mi][1][i + 1];
          const float a = u0 * __builtin_amdgcn_rcpf(1.f + __expf(-u0)) * g0, b2 = u1 * __builtin_amdgcn_rcpf(1.f + __expf(-u1)) * g1;
          const float recv = dpp_f(odd ? a : b2, 0);
          const int row = m0e + rb + mi * 32 + (i & 3) + 8 * (i >> 2) + (odd ? 1 : 0);
          const unsigned w = odd ? pack2(recv, b2) : pack2(a, recv);
          __builtin_nontemporal_store(w, (unsigned*)(P.pbuf + (size_t)row * DFF + (hb & ~1)));
        }
    }
  }
}

__device__ void phase_attnprep(const Params& P, int l, unsigned char* smem, int bid, int nb, const int dummy = 0) {
  const int tid = opaque_tid(), lane = tid & 63, wave = tid >> 6;
  for (int m = bid * 4 + wave; m < MALL; m += nb * 4) {
    const int b = m / TALL, t = m - b * TALL;
    const bool isctx = t < CTX;
    const int tp = t - CTX, rowp = tp >> 6, colp = tp & 63;
    u16* pr = P.pbuf + (size_t)m * INW;
    float xv[22];
#pragma unroll
    for (int ch = 0; ch < 22; ++ch) {
      const int col = ch < 4 ? 960 + ch * 64 : (ch < 6 ? 1216 + (ch - 4) * 64 : (ch < 10 ? 1472 + (ch - 6) * 64 : (ch < 14 ? 1728 + (ch - 10) * 64 : (ch < 18 ? 2240 + (ch - 14) * 64 : 2496 + (ch - 18) * 64))));
      xv[ch] = bf2f(pr[col + lane]);
    }
    float csA = 1.f, snA = 0.f, csD = 1.f, snD = 0.f, csR = 1.f, snR = 0.f;
    if (!isctx) {
      { const int e = lane & 31, pos = (lane >> 5) ? colp : rowp, i = e & 15; csA = P.ropeA[(pos * 16 + i) * 2]; snA = P.ropeA[(pos * 16 + i) * 2 + 1]; if (e < 16) snA = -snA; }
      { const int e = lane & 15, pos = ((lane >> 4) & 1) ? colp : rowp, i = e & 7; csD = P.ropeD[(pos * 8 + i) * 2]; snD = P.ropeD[(pos * 8 + i) * 2 + 1]; if (e < 8) snD = -snD; }
      { const int i = lane & 31; csR = P.ropeR[(tp * 32 + i) * 2]; snR = P.ropeR[(tp * 32 + i) * 2 + 1]; if (lane < 32) snR = -snR; }
    }
    const float gq = P.gqa_q_norm[l * 64 + lane], gk = P.gqa_k_norm[l * 64 + lane];
#pragma unroll
    for (int ch = 0; ch < 22; ++ch) {
      const int col = ch < 4 ? 960 + ch * 64 : (ch < 6 ? 1216 + (ch - 4) * 64 : (ch < 10 ? 1472 + (ch - 6) * 64 : (ch < 14 ? 1728 + (ch - 10) * 64 : (ch < 18 ? 2240 + (ch - 14) * 64 : 2496 + (ch - 18) * 64))));
      float x = xv[ch];
      if (ch < 6) {
        const float ss = wave_sum(x * x);
        x = x * rsqrtf(ss * (1.f / 64.f) + 1e-6f) * (ch < 4 ? gq : gk);
        const float partner = __shfl_xor(x, 16);
        x = x * csA + partner * snA;
        if (ch < 4) x *= 0.125f * LOG2E;
      } else if (ch < 14) {
        const float partner = __shfl_xor(x, 8);
        x = x * csD + partner * snD;
        if (ch < 10) x *= 0.17677669529663687f * LOG2E;
      } else {
        const float partner = __shfl_xor(x, 32);
        x = x * csR + partner * snR;
        if (ch >= 18) x *= 0.125f;
      }
      if (dummy) { asm volatile("" :: "v"(x)); x = xv[ch]; }
      pr[col + lane] = f2bf(x);
    }
  }
}

__device__ void scan_item(const Params& P, int l, int item, unsigned char* smem, const int pm = 0) {
  float* prep = (float*)smem;
  u16* raw = (u16*)(smem + 49152);
  u16* twb = (u16*)(smem + 49152 + 17408);
  u16* tab = twb + 32 * 40;
  float* ybuf = (float*)(smem + 49152 + 17408 + 8192);
  const int tid = opaque_tid(), lane = tid & 63, wave = tid >> 6;
  __builtin_amdgcn_s_setprio(3);
  const int dir = item >> 7, b = (item >> 3) & 15, hh = (item >> 1) & 3, hf = item & 1;
  const int c = tid;
  int pcol;
  if (c < 64) pcol = hh * 64 + c; else if (c < 128) pcol = 256 + hh * 64 + (c - 64); else if (c < 192) pcol = 512 + hh * 64 + (c - 128);
  else if (c < 224) pcol = 768 + dir * 32 + (c - 192); else pcol = 832 + dir * 32 + (c - 224);
  const float mu = P.rwkv_mu[l * 960 + pcol];
  const int kB = tid & 63, tg = tid >> 6;
  const int wv = __builtin_amdgcn_readfirstlane(wave);
  bf16x8 bfr0, bfr1;
  {
    const float* up = ((wv >> 1) ? P.rwkv_a_up : P.rwkv_w_up) + ((size_t)((l * 2 + dir) * 32)) * 256 + hh * 64 + (wv & 1) * 32 + (lane & 31);
    const int hq = lane >> 5;
    u32x4 t0, t1;
#pragma unroll
    for (int jj = 0; jj < 4; ++jj) {
      t0[jj] = pack2(up[(size_t)(8 * hq + 2 * jj) * 256], up[(size_t)(8 * hq + 2 * jj + 1) * 256]);
      t1[jj] = pack2(up[(size_t)(16 + 8 * hq + 2 * jj) * 256], up[(size_t)(16 + 8 * hq + 2 * jj + 1) * 256]);
    }
    bfr0 = __builtin_bit_cast(bf16x8, t0); bfr1 = __builtin_bit_cast(bf16x8, t1);
  }
  const float w0 = P.rwkv_w0[(l * 2 + dir) * 256 + hh * 64 + kB], a0 = P.rwkv_a0[(l * 2 + dir) * 256 + hh * 64 + kB];
  const float ka = P.rwkv_k_a[l * 256 + hh * 64 + kB], rk = P.rwkv_r_k[(l * 4 + hh) * 64 + kB];
  const float kkwB = P.rwkv_k_k[l * 256 + hh * 64 + kB];
  const int vec = tid & 31;
  int vcol;
  if (vec < 8) vcol = hh * 64 + vec * 8; else if (vec < 16) vcol = 256 + hh * 64 + (vec - 8) * 8; else if (vec < 24) vcol = 512 + hh * 64 + (vec - 16) * 8;
  else if (vec < 28) vcol = 768 + dir * 32 + (vec - 24) * 8; else vcol = 832 + dir * 32 + (vec - 28) * 8;
  const u16* pb = P.pbuf + (size_t)(b * TALL) * INW + vcol;
  f32v2 S0 = {0.f, 0.f}, S1 = S0, S2 = S0, S3 = S0;
  const int rowl = wave * 8 + (lane >> 3), ks = lane & 7;
  uint4 rg0 = make_uint4(0, 0, 0, 0), rg1 = rg0, rg2 = rg0, rg3 = rg0, rg4 = rg0;

  for (int ch = -1; ch < 72; ++ch) {
    const int nx = ch + 1;
    const bool more = nx < 72;
    if (more) {
      const int n0 = nx * 32; const bool cx = n0 < 256;
      const int tlo = dir ? (cx ? 224 - n0 : 2528 - n0) : n0;
      const int slo = cx ? 0 : 256, shi = cx ? 256 : 2304;
      rg0 = *(const uint4*)(pb + (size_t)(tlo + (tid >> 5)) * INW);
      rg1 = *(const uint4*)(pb + (size_t)(tlo + (tid >> 5) + 8) * INW);
      rg2 = *(const uint4*)(pb + (size_t)(tlo + (tid >> 5) + 16) * INW);
      rg3 = *(const uint4*)(pb + (size_t)(tlo + (tid >> 5) + 24) * INW);
      rg4 = make_uint4(0, 0, 0, 0);
      if (tid < 64) { const int tok = (tid >> 5) ? tlo + 32 : tlo - 1; if (tok >= slo && tok < shi) rg4 = *(const uint4*)(pb + (size_t)tok * INW); }
    }
    if (ch >= 0 && !(pm & 1)) {
      {
        const float* psb = prep + ks * 8;
        const float* pvb = prep + 320 + hf * 32 + rowl;
        float4 nap0 = *(const float4*)(psb), nap1 = *(const float4*)(psb + 4);
        float4 nw0 = *(const float4*)(psb + 64), nw1 = *(const float4*)(psb + 68);
        float4 nbp0 = *(const float4*)(psb + 128), nbp1 = *(const float4*)(psb + 132);
        float4 nkd0 = *(const float4*)(psb + 192), nkd1 = *(const float4*)(psb + 196);
        float4 nr0 = *(const float4*)(psb + 256), nr1 = *(const float4*)(psb + 260);
        float nvv = pvb[0];
#pragma unroll 2
        for (int step = 0; step < 32; ++step) {
          const float4 ap0 = nap0, ap1 = nap1, w0v = nw0, w1v = nw1, bp0 = nbp0, bp1 = nbp1, kd0 = nkd0, kd1 = nkd1, r0 = nr0, r1 = nr1;
          const float vv = nvv;
          {
            const int nxs = (step < 31) ? step + 1 : 31;
            const float* ps = psb + nxs * 384;
            nap0 = *(const float4*)(ps); nap1 = *(const float4*)(ps + 4);
            nw0 = *(const float4*)(ps + 64); nw1 = *(const float4*)(ps + 68);
            nbp0 = *(const float4*)(ps + 128); nbp1 = *(const float4*)(ps + 132);
            nkd0 = *(const float4*)(ps + 192); nkd1 = *(const float4*)(ps + 196);
            nr0 = *(const float4*)(ps + 256); nr1 = *(const float4*)(ps + 260);
            nvv = pvb[nxs * 384];
          }
          f32v2 t = S0 * (f32v2){ap0.x, ap0.y};
          t = S1 * (f32v2){ap0.z, ap0.w} + t;
          t = S2 * (f32v2){ap1.x, ap1.y} + t;
          t = S3 * (f32v2){ap1.z, ap1.w} + t;
          const float sa = reduce8(t.x + t.y);
          const f32v2 sa2 = {sa, sa}, vv2 = {vv, vv};
          S0 = S0 * (f32v2){w0v.x, w0v.y} + (sa2 * (f32v2){bp0.x, bp0.y} + vv2 * (f32v2){kd0.x, kd0.y});
          S1 = S1 * (f32v2){w0v.z, w0v.w} + (sa2 * (f32v2){bp0.z, bp0.w} + vv2 * (f32v2){kd0.z, kd0.w});
          S2 = S2 * (f32v2){w1v.x, w1v.y} + (sa2 * (f32v2){bp1.x, bp1.y} + vv2 * (f32v2){kd1.x, kd1.y});
          S3 = S3 * (f32v2){w1v.z, w1v.w} + (sa2 * (f32v2){bp1.z, bp1.w} + vv2 * (f32v2){kd1.z, kd1.w});
          f32v2 u = S0 * (f32v2){r0.x, r0.y};
          u = S1 * (f32v2){r0.z, r0.w} + u;
          u = S2 * (f32v2){r1.x, r1.y} + u;
          u = S3 * (f32v2){r1.z, r1.w} + u;
          const float y = reduce8(u.x + u.y);
          if (ks == 0) ybuf[step * 32 + rowl] = y;
        }
      }
      __syncthreads();
      {
        const int step = tid >> 3, q = tid & 7;
        const int n = ch * 32 + step;
        const int tok = dir ? (n < 256 ? 255 - n : 2559 - n) : n;
        float4 yv = *(const float4*)(ybuf + step * 32 + q * 4);
        if (!(pm & 8)) { uint2 w; w.x = pack2(yv.x, yv.y); w.y = pack2(yv.z, yv.w); *(uint2*)(P.yd + ((size_t)(dir * MALL + b * TALL + tok)) * 256 + hh * 64 + hf * 32 + q * 4) = w; }
      }
    }
    if (more) {
      *(uint4*)(raw + (1 + (tid >> 5)) * 256 + vec * 8) = rg0;
      *(uint4*)(raw + (9 + (tid >> 5)) * 256 + vec * 8) = rg1;
      *(uint4*)(raw + (17 + (tid >> 5)) * 256 + vec * 8) = rg2;
      *(uint4*)(raw + (25 + (tid >> 5)) * 256 + vec * 8) = rg3;
      if (tid < 64) *(uint4*)(raw + ((tid >> 5) ? 33 : 0) * 256 + vec * 8) = rg4;
      __syncthreads();
      if (!(pm & 2)) {
        float pv[34];
#pragma unroll
        for (int j = 0; j < 34; ++j) pv[j] = bf2f(raw[j * 256 + c]);
        if (wv < 3) {
          float* pdst = prep + (wv == 0 ? 256 + c : (wv == 1 ? 192 + (c - 64) : 320 + (c - 128)));
#pragma unroll
          for (int j = 0; j < 32; ++j) {
            const float psv = pv[j + 1] + mu * (0.5f * (pv[j] + pv[j + 2]) - pv[j + 1]);
            pdst[(dir ? 31 - j : j) * 384] = psv;
          }
        } else {
          u16* tdst = ((c < 224) ? twb : tab) + ((c - 192) & 31);
#pragma unroll
          for (int j = 0; j < 32; ++j) {
            const float psv = pv[j + 1] + mu * (0.5f * (pv[j] + pv[j + 2]) - pv[j + 1]);
            const float th = 1.f - 2.f * __builtin_amdgcn_rcpf(__expf(2.f * psv) + 1.f);
            tdst[(dir ? 31 - j : j) * 40] = f2bf((c < 224) ? th : psv);
          }
        }
      }
      __syncthreads();
      if (!(pm & 4)) {
        const int r = lane & 31, hq = lane >> 5;
        const u16* asrc = ((wv >> 1) ? tab : twb) + r * 40 + 8 * hq;
        const bf16x8 af0 = *(const bf16x8*)(asrc), af1 = *(const bf16x8*)(asrc + 16);
        f32x16 accl;
#pragma unroll
        for (int i = 0; i < 16; ++i) accl[i] = 0.f;
        accl = MFMA32(af0, bfr0, accl);
        accl = MFMA32(af1, bfr1, accl);
        float* odst = prep + ((wv >> 1) ? 128 : 64) + (wv & 1) * 32 + r;
#pragma unroll
        for (int i = 0; i < 16; ++i) odst[crow(i, hq) * 384] = accl[i];
      }
      __syncthreads();
      if (!(pm & 4)) {
        const int n0 = nx * 32;
#pragma unroll 2
        for (int s = 0; s < 8; ++s) {
          const int step = tg * 8 + s;
          float* pp = prep + step * 384;
          const float wacc = w0 + pp[64 + kB], aacc = a0 + pp[128 + kB];
          const float sg = __builtin_amdgcn_rcpf(1.f + __expf(-wacc));
          const float decay = __expf(-0.6065306597126334f * sg);
          const float av = __builtin_amdgcn_rcpf(1.f + __expf(-aacc));
          const float ksv = pp[192 + kB];
          const float xk = ksv * kkwB;
          const float kk = xk * rsqrtf(fmaxf(wave_sum(xk * xk), 1e-24f));
          const float kd = ksv * (1.f + (av - 1.f) * ka);
          pp[64 + kB] = decay; pp[192 + kB] = kd; pp[128 + kB] = kk * av; pp[kB] = -kk;
          const float cs = wave_sum(pp[256 + kB] * kd * rk);
          if (lane == 0 && hf == 0 && !(pm & 8)) {
            const int n = n0 + step;
            const int tok = dir ? (n < 256 ? 255 - n : 2559 - n) : n;
            P.cbuf[((size_t)(dir * MALL + b * TALL + tok)) * 4 + hh] = cs;
          }
        }
      }
    }
    __syncthreads();
  }
  __builtin_amdgcn_s_setprio(0);
}

template <int KIND>
__device__ void attn_item(const Params& P, int l, int b, int hh, int qb, bool isctx, unsigned char* smem) {
  constexpr int NMAP = (KIND == 1) ? 2 : 1;
  constexpr int NKS = (KIND == 1) ? 2 : 4;
  u16* sK = (u16*)smem;
  u16* sV = sK + 2 * 64 * 72;
  float* stash = (float*)(smem + 4 * 64 * 72 * 2);
  const int tid = opaque_tid(), lane = tid & 63, wave = tid >> 6, r = lane & 31, h = lane >> 5;
  int qcol, kcol, vh, ycol;
  if (KIND == 0) { qcol = 960 + hh * 64; kcol = 1216 + (hh >> 1) * 64; vh = hh >> 1; ycol = 256 + hh * 64; }
  else if (KIND == 1) { qcol = 1472 + hh * 64; kcol = 1728 + hh * 64; vh = 2 + hh; ycol = 512 + hh * 64; }
  else { qcol = 2240 + hh * 64; kcol = 2496 + hh * 64; vh = 6 + hh; ycol = 768 + hh * 64; }
  const int iq = qb * 128 + wave * 32 + r;
  const int tq = b * TALL + (isctx ? 0 : CTX) + iq;
  const int ntiles = isctx ? 4 : 36;
  float lgf = 0.f, lgb = 0.f;
  if (KIND == 2) { lgf = log2f(1.f - exp2f(-5.f - (float)hh)); lgb = log2f(1.f - exp2f(-5.f - (float)(3 - hh))); }
  float cf[16], cb[16], ckf = 1.f, ckb = 1.f;
  if (KIND == 2) {
#pragma unroll
    for (int i = 0; i < 16; ++i) {
      const float o_ = (float)crow(i, h);
      cf[i] = __builtin_amdgcn_exp2f(-o_ * lgf);
      cb[i] = __builtin_amdgcn_exp2f(o_ * lgb);
    }
    ckf = __builtin_amdgcn_exp2f(-32.f * lgf); ckb = __builtin_amdgcn_exp2f(32.f * lgb);
  }
  const int q0w = qb * 128 + wave * 32;
  const int lrow = tid >> 3, lvec = tid & 7;
  const u16* Kg = P.pbuf + (size_t)(b * TALL + lrow) * INW + kcol + lvec * 8;
  const u16* Vg = P.vt + ((size_t)((b * 10 + vh) * 64 + lrow)) * TALL + lvec * 8;
  float o[2][16];
  {
    bf16x8 qf[NMAP][NKS];
    f32x16 O[NMAP][2];
    float mrun[NMAP], lsum[NMAP];
#pragma unroll
    for (int mp = 0; mp < NMAP; ++mp) {
      mrun[mp] = 0.f; lsum[mp] = 0.f;
#pragma unroll
      for (int ks = 0; ks < NKS; ++ks) qf[mp][ks] = *(const bf16x8*)(P.pbuf + (size_t)tq * INW + qcol + mp * 32 + ks * 16 + h * 8);
#pragma unroll
      for (int dt = 0; dt < 2; ++dt)
#pragma unroll
        for (int i = 0; i < 16; ++i) O[mp][dt][i] = 0.f;
    }
    uint4 xk0, xk1, xv0, xv1;
#define ATT_LOAD(S, t_) { S##k0 = *(const uint4*)(Kg + (size_t)((t_) * 64) * INW); S##k1 = *(const uint4*)(Kg + (size_t)((t_) * 64 + 32) * INW); \
      S##v0 = *(const uint4*)(Vg + (t_) * 64); S##v1 = *(const uint4*)(Vg + (size_t)32 * TALL + (t_) * 64); }
#define ATT_STORE(S, st_) { u16* k2 = sK + (st_) * (64 * 72); u16* v2 = sV + (st_) * (64 * 72); \
      *(uint4*)(k2 + lrow * 72 + lvec * 8) = S##k0; *(uint4*)(k2 + (lrow + 32) * 72 + lvec * 8) = S##k1; \
      *(uint4*)(v2 + lrow * 72 + lvec * 8) = S##v0; *(uint4*)(v2 + (lrow + 32) * 72 + lvec * 8) = S##v1; }
#define ATT_COMPUTE(t_, st_) { \
      const int t = (t_); \
      const u16* k_ = sK + (st_) * (64 * 72); \
      const u16* v_ = sV + (st_) * (64 * 72); \
      _Pragma("unroll") for (int mp = 0; mp < NMAP; ++mp) { \
      f32x16 st[2]; \
      const float sinit = (KIND != 2 && t > 0) ? -mrun[mp] : 0.f;     \
      _Pragma("unroll") for (int kt = 0; kt < 2; ++kt) { \
        _Pragma("unroll") for (int i = 0; i < 16; ++i) st[kt][i] = sinit; \
        _Pragma("unroll") for (int ks = 0; ks < NKS; ++ks) { \
          bf16x8 kf = *(const bf16x8*)(k_ + (kt * 32 + r) * 72 + mp * 32 + ks * 16 + h * 8); \
          st[kt] = MFMA32(kf, qf[mp][ks], st[kt]); \
        } \
      } \
      int rmode = 0; float rff = 0.f, rbb = 0.f; \
      if (KIND == 2) { \
        const int kb = t * 64 - (isctx ? 0 : 256); \
        if (!isctx && t < 4) { rmode = 3; rff = __builtin_amdgcn_exp2f((float)(iq - kb) * lgf); rbb = __builtin_amdgcn_exp2f((float)(2048 - iq + t * 64) * lgb); } \
        else if (kb + 63 < q0w) { rmode = 1; rff = __builtin_amdgcn_exp2f((float)(iq - kb) * lgf); } \
        else if (kb > q0w + 31) { rmode = 2; rbb = __builtin_amdgcn_exp2f((float)(kb - iq) * lgb); } \
      } \
      if (KIND != 2) { \
        float mx = st[0][0]; \
        _Pragma("unroll") for (int kt = 0; kt < 2; ++kt) \
          _Pragma("unroll") for (int i = 0; i < 16; ++i) mx = fmaxf(mx, st[kt][i]); \
        mx = xhalf_max(mx); \
        if (t == 0) {                        \
          mrun[mp] = mx; \
          _Pragma("unroll") for (int kt = 0; kt < 2; ++kt) \
            _Pragma("unroll") for (int i = 0; i < 16; ++i) st[kt][i] -= mx; \
        } else if (__builtin_amdgcn_ballot_w64(mx > 8.f) != 0ull) {     \
          const float delta = fmaxf(mx, 0.f); \
          const float alpha = __builtin_amdgcn_exp2f(-delta); \
          mrun[mp] += delta; \
          lsum[mp] *= alpha; \
          _Pragma("unroll") for (int kt = 0; kt < 2; ++kt) \
            _Pragma("unroll") for (int i = 0; i < 16; ++i) st[kt][i] -= delta; \
          _Pragma("unroll") for (int dt = 0; dt < 2; ++dt) \
            _Pragma("unroll") for (int i = 0; i < 16; ++i) O[mp][dt][i] *= alpha; \
        } \
      } \
      _Pragma("unroll") for (int kt = 0; kt < 2; ++kt) { \
        if (KIND != 2) { \
          f32v2 ps2 = {0.f, 0.f}; \
          _Pragma("unroll") for (int i = 0; i < 16; i += 2) { \
            const float p0 = __builtin_amdgcn_exp2f(st[kt][i]), p1 = __builtin_amdgcn_exp2f(st[kt][i + 1]); \
            st[kt][i] = p0; st[kt][i + 1] = p1; ps2 += (f32v2){p0, p1}; } \
          lsum[mp] += ps2.x + ps2.y; \
        } else if (rmode != 0) { \
          const float rf_ = kt ? rff * ckf : rff, rb_ = kt ? rbb * ckb : rbb; \
          _Pragma("unroll") for (int i = 0; i < 16; ++i) st[kt][i] *= rf_ * cf[i] + rb_ * cb[i]; \
        } else { \
          const int kbase = t * 64 - (isctx ? 0 : 256); \
          _Pragma("unroll") for (int i = 0; i < 16; ++i) { \
            const int df = iq - (kbase + kt * 32 + crow(i, h)); \
            const float e = __builtin_amdgcn_exp2f(df > 0 ? (float)df * lgf : (float)(-df) * lgb); \
            st[kt][i] *= (df == 0) ? 2.f : e; \
          } \
        } \
        _Pragma("unroll") for (int s = 0; s < 2; ++s) { \
          u32x4 pbu; \
          pbu[0] = pack2(st[kt][8 * s + 0], st[kt][8 * s + 1]); pbu[1] = pack2(st[kt][8 * s + 2], st[kt][8 * s + 3]); \
          pbu[2] = pack2(st[kt][8 * s + 4], st[kt][8 * s + 5]); pbu[3] = pack2(st[kt][8 * s + 6], st[kt][8 * s + 7]); \
          const bf16x8 pbv = __builtin_bit_cast(bf16x8, pbu); \
          _Pragma("unroll") for (int dt = 0; dt < 2; ++dt) { \
            const bf16x8 vfv = *(const bf16x8*)(v_ + (dt * 32 + r) * 72 + kt * 32 + s * 16 + 8 * h);     \
            O[mp][dt] = MFMA32(vfv, pbv, O[mp][dt]); \
          } \
        } \
      } \
      } }
    ATT_LOAD(x, 0);
    ATT_STORE(x, 0);
    __syncthreads();
    for (int tt = 0; tt < ntiles; ++tt) {
      const int cur = tt & 1;
      if (tt + 1 < ntiles) ATT_LOAD(x, tt + 1);
      ATT_COMPUTE(tt, cur);
      if (tt + 1 < ntiles) ATT_STORE(x, cur ^ 1);
      __syncthreads();
    }
#undef ATT_LOAD
#undef ATT_STORE
#undef ATT_COMPUTE
    if (KIND == 0) {
      const float inv = 1.f / (lsum[0] + __shfl_xor(lsum[0], 32));
#pragma unroll
      for (int dt = 0; dt < 2; ++dt)
#pragma unroll
        for (int i = 0; i < 16; ++i) o[dt][i] = O[0][dt][i] * inv;
    } else if (KIND == 1) {
      const float inv0 = 1.f / (lsum[0] + __shfl_xor(lsum[0], 32));
      const float inv1 = P.lamv[l * 2] / (lsum[NMAP - 1] + __shfl_xor(lsum[NMAP - 1], 32));
#pragma unroll
      for (int dt = 0; dt < 2; ++dt)
#pragma unroll
        for (int i = 0; i < 16; ++i) o[dt][i] = O[0][dt][i] * inv0 - O[NMAP - 1][dt][i] * inv1;
    } else {
#pragma unroll
      for (int dt = 0; dt < 2; ++dt)
#pragma unroll
        for (int i = 0; i < 16; ++i) o[dt][i] = O[0][dt][i];
    }
  }
  if (KIND == 1) {
    float ss = 0.f;
#pragma unroll
    for (int dt = 0; dt < 2; ++dt)
#pragma unroll
      for (int i = 0; i < 16; ++i) ss += o[dt][i] * o[dt][i];
    ss += __shfl_xor(ss, 32);
    const float sc = rsqrtf(ss * (1.f / 64.f) + 1e-6f) * (1.f - P.lamv[l * 2 + 1]);
#pragma unroll
    for (int dt = 0; dt < 2; ++dt)
#pragma unroll
      for (int i = 0; i < 16; ++i) o[dt][i] *= sc * P.diff_norm[l * 64 + dt * 32 + crow(i, h)];
  } else if (KIND == 2) {
    float s = 0.f;
#pragma unroll
    for (int dt = 0; dt < 2; ++dt)
#pragma unroll
      for (int i = 0; i < 16; ++i) s += o[dt][i];
    s += __shfl_xor(s, 32);
    const float mean = s * (1.f / 64.f);
    float q = 0.f;
#pragma unroll
    for (int dt = 0; dt < 2; ++dt)
#pragma unroll
      for (int i = 0; i < 16; ++i) { const float x = o[dt][i] - mean; o[dt][i] = x; q += x * x; }
    q += __shfl_xor(q, 32);
    const float rstd = rsqrtf(q * (1.f / 64.f) + 1e-5f);
#pragma unroll
    for (int dt = 0; dt < 2; ++dt)
#pragma unroll
      for (int g = 0; g < 4; ++g) {
        const int d0 = dt * 32 + 8 * g + 4 * h;
        const uint2 gt = *(const uint2*)(P.pbuf + (size_t)tq * INW + 3008 + hh * 64 + d0);
        const float g0 = bf2f((u16)(gt.x & 0xffff)), g1 = bf2f((u16)(gt.x >> 16)), g2 = bf2f((u16)(gt.y & 0xffff)), g3 = bf2f((u16)(gt.y >> 16));
        o[dt][4 * g + 0] *= rstd * g0 / (1.f + __expf(-g0));
        o[dt][4 * g + 1] *= rstd * g1 / (1.f + __expf(-g1));
        o[dt][4 * g + 2] *= rstd * g2 / (1.f + __expf(-g2));
        o[dt][4 * g + 3] *= rstd * g3 / (1.f + __expf(-g3));
      }
  }
#pragma unroll
  for (int dt = 0; dt < 2; ++dt)
#pragma unroll
    for (int g = 0; g < 4; ++g) {
      const int d0 = dt * 32 + 8 * g + 4 * h;
      uint2 w;
      w.x = pack2(o[dt][4 * g], o[dt][4 * g + 1]);
      w.y = pack2(o[dt][4 * g + 2], o[dt][4 * g + 3]);
      *(uint2*)(P.abuf + (size_t)tq * D + ycol + d0) = w;
    }
}

__device__ void phase_mixers(const Params& P, int l, unsigned char* smem, int cbase = 0, int mode = 0) {
  __shared__ int s_item;
  const int natt = (mode == 1 || mode == 3) ? 0 : 3072 + (l < NL - 1 ? 384 : 0);
  unsigned* qatt = P.counters + cbase + l;
  unsigned* qscan = P.counters + cbase + 16 + l;
  if (threadIdx.x == 0) {
    const unsigned key = xb_xcc_id() * 256u + ((unsigned)__builtin_amdgcn_s_getreg((6 << 11) | (8 << 6) | 4) & 0x7Fu);
    const unsigned slot = atomicAdd(P.cucnt + key, 1u);
    int it = -1;
    if ((slot & 1u) == 0u && mode != 2) { it = (int)atomicAdd(qscan, 1u); if (it >= 256) it = -1; }
    s_item = it;
  }
  __syncthreads();
  {
    const int it = s_item;
    __syncthreads();
    if (it >= 0) scan_item(P, l, it, smem, (mode == 3) ? (8 | SCAN_PM) : 0);
  }
  for (;;) {
    if (threadIdx.x == 0) s_item = (int)atomicAdd(qatt, 1u);
    __syncthreads();
    const int item = s_item;
    __syncthreads();
    if (item >= natt) break;
    int idx = item;
    int kind, b, hh, qb; bool isctx;
    if (idx < 3072) { kind = idx >> 10; kind = (kind == 0) ? 1 : (kind == 1 ? 0 : 2); int rem = idx & 1023; b = rem >> 6; hh = (rem >> 4) & 3; qb = rem & 15; isctx = false; }
    else { idx -= 3072; kind = idx >> 7; int rem = idx & 127; b = rem >> 3; hh = (rem >> 1) & 3; qb = rem & 1; isctx = true; }
    if (kind == 0) attn_item<0>(P, l, b, hh, qb, isctx, smem);
    else if (kind == 1) attn_item<1>(P, l, b, hh, qb, isctx, smem);
    else attn_item<2>(P, l, b, hh, qb, isctx, smem);
  }
  for (;;) {
    if (threadIdx.x == 0) s_item = (int)atomicAdd(qscan, 1u);
    __syncthreads();
    const int item = s_item;
    __syncthreads();
    if (item >= 256 || mode == 2 || mode == 3) break;
    scan_item(P, l, item, smem);
  }
}

__device__ void phase_rwkv_combine(const Params& P, int l, unsigned char* smem, int bid, int nb) {
  float* sg = (float*)smem;
  const int tid = opaque_tid(), wave = tid >> 6, c = tid;
  float gup[64];
#pragma unroll
  for (int r = 0; r < 64; ++r) gup[r] = P.rwkv_g_up[((size_t)(l * 64 + r)) * 256 + c];
  const float lng = P.rwkv_ln_g[l * 256 + c], lnb = P.rwkv_ln_b[l * 256 + c], mu_v = P.rwkv_mu[l * 960 + 512 + c];
  const float mu_g = P.rwkv_mu[l * 960 + 896 + (tid & 63)];
  const bool latent_only = (l == NL - 1);
  for (int tile = bid; tile < MALL / 16; tile += nb) {
    const int m0 = tile * 16, b = m0 / TALL, t0 = m0 - b * TALL;
    const bool isctx = t0 < CTX;
    if (latent_only && isctx) continue;
    const int seglo = b * TALL + (isctx ? 0 : CTX), seghi = b * TALL + (isctx ? CTX : TALL);
#pragma unroll
    for (int i = 0; i < 4; ++i) {
      const int idx = tid + 256 * i, tok = idx >> 6, r = idx & 63;
      const int m = m0 + tok;
      const u16* pp = P.pbuf + (size_t)m * INW + 896 + r;
      const float pc = bf2f(pp[0]);
      const float pm = (m - 1 >= seglo) ? bf2f(*(pp - INW)) : 0.f;
      const float pn = (m + 1 < seghi) ? bf2f(*(pp + INW)) : 0.f;
      const float ps = pc + mu_g * (0.5f * (pm + pn) - pc);
      sg[tok * 64 + r] = 1.f / (1.f + expf(-ps));
    }
    __syncthreads();
#pragma unroll 1
    for (int tq4 = 0; tq4 < 16; tq4 += 4) {
      float ya[4], yb[4], pcv[4], pmv[4], pnv[4], csa[4], csb[4];
#pragma unroll
      for (int u = 0; u < 4; ++u) {
        const int m = m0 + tq4 + u;
        ya[u] = bf2f(P.yd[((size_t)m) * 256 + c]); yb[u] = bf2f(P.yd[((size_t)(MALL + m)) * 256 + c]);
        const u16* pv = P.pbuf + (size_t)m * INW + 512 + c;
        pcv[u] = bf2f(pv[0]);
        pmv[u] = (m - 1 >= seglo) ? bf2f(*(pv - INW)) : 0.f;
        pnv[u] = (m + 1 < seghi) ? bf2f(*(pv + INW)) : 0.f;
        csa[u] = P.cbuf[((size_t)m) * 4 + wave]; csb[u] = P.cbuf[((size_t)(MALL + m)) * 4 + wave];
      }
#pragma unroll
      for (int u = 0; u < 4; ++u) {
        const int tok = tq4 + u, m = m0 + tok;
        float gacc = 0.f;
#pragma unroll
        for (int r = 0; r < 64; r += 4) {
          const float4 s4 = *(const float4*)(sg + tok * 64 + r);
          gacc += s4.x * gup[r] + s4.y * gup[r + 1] + s4.z * gup[r + 2] + s4.w * gup[r + 3];
        }
        const float y = ya[u] + yb[u];
        const float mean = wave_sum(y) * (1.f / 64.f);
        const float dd = y - mean;
        const float var = wave_sum(dd * dd) * (1.f / 64.f);
        const float yn = dd * rsqrtf(var + 64e-5f) * lng + lnb;
        const float vs = pcv[u] + mu_v * (0.5f * (pmv[u] + pnv[u]) - pcv[u]);
        P.abuf[(size_t)m * D + c] = f2bf((yn + (csa[u] + csb[u]) * vs) * gacc);
      }
    }
    __syncthreads();
  }
}

__device__ void run_phase(const Params& P, int ph, unsigned char* smem, int bid, int nb, const XcdBarrier* xbp) {
  if (ph == 1 + 9 * NL) { phase_prep(P, NL - 1, 2, bid, nb); return; }
  const int l = (ph - 1) / 9, s = (ph - 1) - l * 9;
  const bool last = (l == NL - 1);
  switch (s) {
    case 0:
      phase_prep(P, l, 0, bid, nb);
      for (int t = bid; t < NWCONV; t += nb) wconv_tile(P, l, t, smem);
      break;
    case 1:
      phase_gemm<EPI_P, false>(P, l, P.abuf, P.w_in_t, D, INWP / 128, smem, bid, nb);
#if PROBE == 1 || PROBE == 13
      phase_gemm<EPI_P, false>(P, l, P.abuf, P.w_in_t, D, INWP / 128, smem, bid, nb);
#elif PROBE == 14
      phase_gemm<EPI_P, false>(P, l, P.abuf, P.w_in_t, D, INWP / 128, smem, bid, nb, 2);
#elif PROBE == 15
      phase_gemm<EPI_P, false>(P, l, P.abuf, P.w_in_t, D, INWP / 128, smem, bid, nb, 3);
#endif
      break;
    case 2:
      phase_attnprep(P, l, smem, bid, nb);
#if PROBE == 9
      phase_attnprep(P, l, smem, bid, nb, 1);
#endif
      break;
    case 3:
      phase_mixers(P, l, smem);
#if PROBE == 6
      xcd_barrier(*xbp);
      phase_mixers(P, l, smem, 32);
#elif PROBE == 2
      xcd_barrier(*xbp);
      phase_mixers(P, l, smem, 32, 1);
#elif PROBE == 3
      xcd_barrier(*xbp);
      phase_mixers(P, l, smem, 32, 2);
#elif PROBE == 8
      xcd_barrier(*xbp);
      phase_mixers(P, l, smem, 32, 3);
#endif
      break;
    case 4:
      phase_rwkv_combine(P, l, smem, bid, nb);
#if PROBE == 5
      phase_rwkv_combine(P, l, smem, bid, nb);
#endif
      break;
    case 5:
      if (last) phase_gemm<EPI_RES1, true>(P, l, P.abuf, P.w_out_t, D, D / 128, smem, bid, nb);
      else phase_gemm<EPI_RES1, false>(P, l, P.abuf, P.w_out_t, D, D / 128, smem, bid, nb);
#if PROBE == 11
      phase_gemm<EPI_RES1, false>(P, l, P.abuf, P.w_out_t, D, D / 128, smem, bid, nb, 1);
#endif
      break;
    case 6:
      phase_prep(P, l, 1, bid, nb);
#if PROBE == 10
      phase_prep(P, l, 1, bid, nb, 1);
#endif
      break;
    case 7:
      if (last) phase_gemm<EPI_SWIGLU, true>(P, l, P.abuf, P.ffn_in_t, D, (2 * DFF) / 128, smem, bid, nb);
      else phase_gemm<EPI_SWIGLU, false>(P, l, P.abuf, P.ffn_in_t, D, (2 * DFF) / 128, smem, bid, nb);
#if PROBE == 1
      phase_gemm<EPI_SWIGLU, false>(P, l, P.abuf, P.ffn_in_t, D, (2 * DFF) / 128, smem, bid, nb);
#endif
      break;
    case 8:
      if (last) phase_gemm<EPI_RES2, true>(P, l, P.pbuf, P.ffn_out_t, DFF, D / 128, smem, bid, nb);
      else phase_gemm<EPI_RES2, false>(P, l, P.pbuf, P.ffn_out_t, DFF, D / 128, smem, bid, nb);
#if PROBE == 12
      phase_gemm<EPI_RES2, false>(P, l, P.pbuf, P.ffn_out_t, DFF, D / 128, smem, bid, nb, 1);
#elif PROBE == 16
      phase_gemm<EPI_RES2, false>(P, l, P.pbuf, P.ffn_out_t, DFF, D / 128, smem, bid, nb, 3);
#endif
      break;
  }
}

__global__ void __launch_bounds__(256, 2) fwd_megakernel(Params P, int ph_begin, int ph_end) {
  __shared__ __attribute__((aligned(16))) unsigned char smem[SMEM_BYTES];
  __shared__ uint4 xb_words;
  cg::grid_group grid = cg::this_grid();
  const int bid = blockIdx.x, nb = gridDim.x;
  if (threadIdx.x == 0) xb_words = make_uint4(0u, 0u, 0u, 0u);
  __syncthreads();
  (void)xcd_barrier_post(P.bar, (volatile LAS unsigned*)&xb_words);
  phase0(P, smem, bid, nb);
#if PROBE == 17
  phase0(P, smem, bid, nb);
#endif
  if (ph_end < 0) grid.sync();
  {
    XcdBarrier xb0; xb0.bar = P.bar; xb0.x = xb_xcc_id(); xb0.st = (volatile LAS unsigned*)&xb_words;
    xcd_barrier(xb0);
  }
  for (int ph = ph_begin + 1; ph < ph_end; ++ph) {
    XcdBarrier xb; xb.bar = P.bar; xb.x = xb_xcc_id(); xb.st = (volatile LAS unsigned*)&xb_words;
    run_phase(P, ph, smem, bid, nb, &xb);
    if (ph + 1 < ph_end) xcd_barrier(xb);
#if PROBE == 4
    xcd_barrier(xb); xcd_barrier(xb);
#endif
  }
}

extern "C" void kernel_launch(void* const* d_in, const int* in_sizes, int n_in, void* d_out, int out_size, void* d_ws,
                              size_t ws_size, hipStream_t stream) {
  Params P{};
  const float** pp = (const float**)&P;
  for (int i = 0; i < 29; ++i) pp[i] = (const float*)d_in[i];
  P.out = (float*)d_out;
  char* ws = (char*)d_ws;
  size_t off = 0;
  auto take = [&](size_t bytes) { char* p = ws + off; off += (bytes + 255) & ~(size_t)255; return p; };
  P.counters = (unsigned*)take(256);
  P.bar = (unsigned*)take(XCD_BAR_WORDS * 4);
  P.cucnt = (unsigned*)take(4096 * 4);
  P.lamv = (float*)take(256);
  P.mod = (float*)take((size_t)NL * 17 * 6144 * 4);
  P.ropeA = (float*)take(64 * 16 * 2 * 4);
  P.ropeD = (float*)take(64 * 8 * 2 * 4);
  P.ropeR = (float*)take(2048 * 32 * 2 * 4);
  P.cbuf = (float*)take((size_t)2 * MALL * 4 * 4);
  P.w_in_t = (u16*)take((size_t)INWP * D * 2);
  P.w_out_t = (u16*)take((size_t)D * D * 2);
  P.ffn_in_t = (u16*)take((size_t)2 * DFF * D * 2);
  P.ffn_out_t = (u16*)take((size_t)D * DFF * 2);
  P.zctx = (float*)take((size_t)NBATCH * CTX * D * 4);
  P.pbuf = (u16*)take((size_t)MALL * INW * 2);
  P.abuf = (u16*)take((size_t)MALL * D * 2);
  P.yd = (u16*)take((size_t)2 * MALL * 256 * 2);
  P.vt = (u16*)take((size_t)NBATCH * 10 * 64 * TALL * 2);
  P.stats = (float*)take((size_t)MALL * 2 * 4);
  if (off > ws_size) fprintf(stderr, "workspace too small: need %zu have %zu\n", off, ws_size);

  static int grid_blocks = 0;
  if (!grid_blocks) {
    int dev = 0, cus = 0, per_cu = 0;
    (void)hipGetDevice(&dev);
    (void)hipDeviceGetAttribute(&cus, hipDeviceAttributeMultiprocessorCount, dev);
    (void)hipOccupancyMaxActiveBlocksPerMultiprocessor(&per_cu, fwd_megakernel, 256, 0);
    if (per_cu > 2) per_cu = 2;
    if (per_cu < 1) per_cu = 1;
    grid_blocks = cus * per_cu;
  }
  (void)hipMemsetAsync(P.counters, 0, 256 + XCD_BAR_WORDS * 4 + 4096 * 4, stream);
  int ph_begin = 0, ph_end = 2 + 9 * NL;
  void* args[] = {&P, &ph_begin, &ph_end};
  hipError_t e = hipLaunchCooperativeKernel((void*)fwd_megakernel, dim3(grid_blocks), dim3(256), args, 0, stream);
  if (e != hipSuccess) fprintf(stderr, "cooperative launch failed: %s (grid %d)\n", hipGetErrorString(e), grid_blocks);
}
```

```cpp
#include <hip/hip_runtime.h>
#include <hip/hip_cooperative_groups.h>
#include <cstdio>
#ifndef PROBE
#define PROBE 0
#endif
#ifndef SCAN_PM
#define SCAN_PM 0
#endif
namespace cg = cooperative_groups;

typedef unsigned short u16;
using bf16x8 = __attribute__((ext_vector_type(8))) short;
using f32x16 = __attribute__((ext_vector_type(16))) float;
using u32x4 = __attribute__((ext_vector_type(4))) unsigned;
#define DI __device__ __forceinline__
#define MFMA32(a, b, c) __builtin_amdgcn_mfma_f32_32x32x16_bf16((a), (b), (c), 0, 0, 0)

static constexpr int D = 1024, NBATCH = 16, SEQ = 2048, CTX = 256, TALL = 2304, MALL = 36864, NL = 4;
static constexpr int INW = 3264, INWP = 3328, DFF = 2816;
static constexpr float ALPHA = 1.681792830507429f;
static constexpr float LOG2E = 1.4426950408889634f;
static constexpr int SMEM_BYTES = 79872;
static constexpr int NWCONV = 3200;
static constexpr size_t WIN_E = (size_t)3328 * 1024, WOUT_E = (size_t)1024 * 1024, FIN_E = (size_t)5632 * 1024, FOUT_E = (size_t)1024 * 2816;

struct Params {
  const float *x, *c, *ctx, *c_ctx, *ada_w, *ada_b, *w_in, *rwkv_mu, *rwkv_w0, *rwkv_w_up, *rwkv_a0, *rwkv_a_up,
      *rwkv_g_up, *rwkv_k_k, *rwkv_k_a, *rwkv_r_k, *rwkv_ln_g, *rwkv_ln_b, *gqa_q_norm, *gqa_k_norm, *diff_lambda,
      *diff_norm, *w_out, *post1_g, *post1_b, *ffn_w_in, *ffn_w_out, *post2_g, *post2_b;
  float* out;
  unsigned* counters;
  unsigned* bar;
  unsigned* cucnt;
  float *lamv, *mod, *ropeA, *ropeD, *ropeR, *cbuf;
  u16 *w_in_t, *w_out_t, *ffn_in_t, *ffn_out_t;
  float* zctx;
  u16 *pbuf, *abuf;
  u16* yd;
  u16* vt;
  float* stats;
};

DI u16 f2bf(float x) { unsigned u = __float_as_uint(x); u += 0x7fffu + ((u >> 16) & 1u); return (u16)(u >> 16); }
DI float bf2f(u16 v) { return __uint_as_float(((unsigned)v) << 16); }
typedef __bf16 bf16v2 __attribute__((ext_vector_type(2)));
typedef float f32v2 __attribute__((ext_vector_type(2)));
DI unsigned pack2(float a, float b) { f32v2 v = {a, b}; bf16v2 r = __builtin_convertvector(v, bf16v2); return __builtin_bit_cast(unsigned, r); }
DI int opaque_tid() { int t = threadIdx.x; asm volatile("" : "+v"(t)); return t; }
DI int crow(int i, int h) { return (i & 3) + 8 * (i >> 2) + 4 * h; }
DI float dpp_f(float x, const int ctrl_sel) {
  int v = __float_as_int(x), r;
  if (ctrl_sel == 0) r = __builtin_amdgcn_update_dpp(0, v, 0xB1, 0xF, 0xF, true);
  else if (ctrl_sel == 1) r = __builtin_amdgcn_update_dpp(0, v, 0x4E, 0xF, 0xF, true);
  else r = __builtin_amdgcn_update_dpp(0, v, 0x141, 0xF, 0xF, true);
  return __int_as_float(r);
}
DI float xhalf_max(float x) {
  const auto r_ = __builtin_amdgcn_permlane32_swap(__float_as_uint(x), __float_as_uint(x), false, false);
  return fmaxf(__uint_as_float(r_[0]), __uint_as_float(r_[1]));
}
DI float xhalf_sum(float x) {
  const auto r_ = __builtin_amdgcn_permlane32_swap(__float_as_uint(x), __float_as_uint(x), false, false);
  return __uint_as_float(r_[0]) + __uint_as_float(r_[1]);
}
DI float reduce8(float x) { x += dpp_f(x, 0); x += dpp_f(x, 1); x += dpp_f(x, 2); return x; }
DI float wave_sum(float x) {
  x += dpp_f(x, 0); x += dpp_f(x, 1); x += dpp_f(x, 2);
  x += __int_as_float(__builtin_amdgcn_update_dpp(0, __float_as_int(x), 0x140, 0xF, 0xF, true));
  const int xi = __float_as_int(x);
  const float a = __int_as_float(__builtin_amdgcn_readlane(xi, 0)), b = __int_as_float(__builtin_amdgcn_readlane(xi, 16));
  const float c = __int_as_float(__builtin_amdgcn_readlane(xi, 32)), d = __int_as_float(__builtin_amdgcn_readlane(xi, 48));
  return (a + b) + (c + d);
}
DI float* xrow_ptr(const Params& P, int m) {
  int b = m / TALL, t = m - b * TALL;
  return t < CTX ? P.zctx + ((size_t)(b * CTX + t)) * D : P.out + ((size_t)(b * SEQ + t - CTX)) * D;
}


#define XB_TMO      128
#define XB_XCNT(j)  (256  + 64 * (j))
#define XB_XSUB(j)  (1280 + 64 * (j))
#define XB_XGEN(j)  (2304 + 64 * (j))
#define XB_TOP      3328
#define XB_TOPGEN   3392
#define XCD_BAR_WORDS 3456
#define XB_SPIN_CAP (1u << 20)
#define LAS __attribute__((address_space(3)))
DI unsigned xb_ld(unsigned* p) { return __hip_atomic_load(p, __ATOMIC_RELAXED, __HIP_MEMORY_SCOPE_AGENT); }
DI unsigned xb_add(unsigned* p, unsigned v) { return __hip_atomic_fetch_add(p, v, __ATOMIC_RELAXED, __HIP_MEMORY_SCOPE_AGENT); }
DI unsigned xb_xcc_id() { return (unsigned)__builtin_amdgcn_s_getreg((3 << 11) | 20) & 0xFu; }
#define XB_SPIN(cond, bar) do { unsigned _sp = 0; while (cond) { __builtin_amdgcn_s_sleep(1); \
    if ((++_sp & 255u) == 0u) { if (xb_ld(&(bar)[XB_TMO])) break; if (_sp > XB_SPIN_CAP) { atomicAdd(&(bar)[XB_TMO], 1u); break; } } } } while (0)
struct XcdBarrier { unsigned* bar; unsigned x; volatile LAS unsigned* st; };
DI XcdBarrier xcd_barrier_post(unsigned* bar, volatile LAS unsigned* st) {
  XcdBarrier b; b.bar = bar; b.x = xb_xcc_id(); b.st = st;
  if (threadIdx.x == 0) (void)xb_add(&bar[XB_XCNT(b.x)], 1u);
  return b;
}
DI void xcd_barrier_complete(unsigned* bar, unsigned x, unsigned& nloc, unsigned& nx) {
  const unsigned G = gridDim.x * gridDim.y * gridDim.z;
  unsigned sum, cnt, mine, sp = 0u;
  for (;;) {
    sum = 0u; cnt = 0u; mine = 0u;
#pragma unroll
    for (unsigned j = 0; j < 16; ++j) { const unsigned c = xb_ld(&bar[XB_XCNT(j)]); sum += c; cnt += (c > 0u) ? 1u : 0u; mine = (j == x) ? c : mine; }
    if (sum == G) break;
    __builtin_amdgcn_s_sleep(1);
    if ((++sp & 255u) == 0u) { if (xb_ld(&bar[XB_TMO])) break; if (sp > XB_SPIN_CAP) { atomicAdd(&bar[XB_TMO], 1u); break; } }
  }
  nloc = mine > 0u ? mine : 1u; nx = cnt > 0u ? cnt : 1u;
}
DI void xcd_barrier(const XcdBarrier& b) {
  asm volatile("s_waitcnt vmcnt(0)" ::: "memory");
  __syncthreads();
  if (threadIdx.x == 0) {
    unsigned* bar = b.bar;
    __builtin_amdgcn_s_waitcnt(0);
    unsigned nloc = b.st[0], nx = b.st[1];
    if (nloc == 0u) { xcd_barrier_complete(bar, b.x, nloc, nx); b.st[0] = nloc; b.st[1] = nx; }
    const unsigned old = xb_add(&bar[XB_XSUB(b.x)], 1u);
    const unsigned gen = old / nloc;
    if (old + 1u == (gen + 1u) * nloc) {
      __builtin_amdgcn_fence(__ATOMIC_RELEASE, "agent");
      asm volatile("s_waitcnt vmcnt(0)" ::: "memory");
      const unsigned og = xb_add(&bar[XB_TOP], 1u);
      const unsigned tg = og / nx;
      if (og + 1u == (tg + 1u) * nx) xb_add(&bar[XB_TOPGEN], 1u);
      else XB_SPIN(xb_ld(&bar[XB_TOPGEN]) == tg, bar);
      __builtin_amdgcn_fence(__ATOMIC_ACQUIRE, "agent");
      xb_add(&bar[XB_XGEN(b.x)], 1u);
      asm volatile("s_waitcnt vmcnt(0)" ::: "memory");
    } else {
      XB_SPIN(xb_ld(&bar[XB_XGEN(b.x)]) == gen, bar);
      __builtin_amdgcn_fence(__ATOMIC_ACQUIRE, "agent");
      asm volatile("s_waitcnt vmcnt(0)" ::: "memory");
    }
  }
  __syncthreads();
}

__device__ void wconv_tile(const Params& P, int l, int tile, unsigned char* smem) {
  float* T = (float*)smem;
  const int tid = opaque_tid();
  const float* src; u16* dst; int ldN, ldK, k0, n0; int kind;
  if (tile < 832) { kind = 0; int nt = tile >> 4, kt = tile & 15; src = P.w_in + (size_t)l * D * INW; ldN = INW; dst = P.w_in_t + (l & 1) * WIN_E; ldK = D; k0 = kt * 64; n0 = nt * 64; }
  else if (tile < 1088) { kind = 1; int t = tile - 832; int nt = t >> 4, kt = t & 15; src = P.w_out + (size_t)l * D * D; ldN = D; dst = P.w_out_t + (l & 1) * WOUT_E; ldK = D; k0 = kt * 64; n0 = nt * 64; }
  else if (tile < 2496) { kind = 2; int t = tile - 1088; int nt = t >> 4, kt = t & 15; src = P.ffn_w_in + (size_t)l * D * (2 * DFF); ldN = 2 * DFF; dst = P.ffn_in_t + (l & 1) * FIN_E; ldK = D; k0 = kt * 64; n0 = nt * 64; }
  else { kind = 3; int t = tile - 2496; int nt = t / 44, kt = t - nt * 44; src = P.ffn_w_out + (size_t)l * DFF * D; ldN = D; dst = P.ffn_out_t + (l & 1) * FOUT_E; ldK = DFF; k0 = kt * 64; n0 = nt * 64; }
  const int j = tid & 63, g = tid >> 6;
  int scol;
  bool zero = false;
  if (kind == 2) { int blk = n0 >> 7, w = (n0 >> 6) & 1; int hb = blk * 64 + w * 32; scol = (j < 32) ? hb + j : DFF + hb + (j - 32); }
  else { scol = n0 + j; if (kind == 0 && scol >= INW) zero = true; }
#pragma unroll 4
  for (int i = 0; i < 16; ++i) {
    int kr = g + 4 * i;
    T[kr * 65 + j] = zero ? 0.f : src[(size_t)(k0 + kr) * ldN + scol];
  }
  __syncthreads();
#pragma unroll 4
  for (int i = 0; i < 16; ++i) {
    int jr = g + 4 * i;
    dst[(size_t)(n0 + jr) * ldK + k0 + j] = f2bf(T[j * 65 + jr]);
  }
  __syncthreads();
}

__device__ void phase0(const Params& P, unsigned char* smem, int bid, int nb) {
  const int tid = opaque_tid();
  const int total = 384 + 256 + 1;
  for (int item = bid; item < total; item += nb) {
    if (item < 384) {
      const int l = item / 96, col0 = (item - l * 96) * 64;
      float* sc = (float*)smem;
      for (int i = tid; i < 17 * 1024; i += 256) {
        int r = i >> 10, k = i & 1023;
        float v = r < 16 ? P.c[r * 1024 + k] : P.c_ctx[k];
        sc[i] = v / (1.f + expf(-v));
      }
      __syncthreads();
      const int col = tid & 63, kq = tid >> 6;
      float acc[17];
#pragma unroll
      for (int r = 0; r < 17; ++r) acc[r] = 0.f;
      const float* w = P.ada_w + ((size_t)l * 1024 + kq * 256) * 6144 + col0 + col;
#pragma unroll 2
      for (int k = 0; k < 256; k += 4) {
        float w0 = w[(size_t)(k + 0) * 6144], w1 = w[(size_t)(k + 1) * 6144], w2 = w[(size_t)(k + 2) * 6144], w3 = w[(size_t)(k + 3) * 6144];
#pragma unroll
        for (int r = 0; r < 17; ++r) {
          float4 s = *(const float4*)(sc + r * 1024 + kq * 256 + k);
          acc[r] += s.x * w0 + s.y * w1 + s.z * w2 + s.w * w3;
        }
      }
      __syncthreads();
      float* red = (float*)smem;
#pragma unroll
      for (int r = 0; r < 17; ++r) red[(kq * 17 + r) * 64 + col] = acc[r];
      __syncthreads();
      for (int i = tid; i < 17 * 64; i += 256) {
        int r = i >> 6, cc = i & 63;
        float s = red[(0 * 17 + r) * 64 + cc] + red[(1 * 17 + r) * 64 + cc] + red[(2 * 17 + r) * 64 + cc] + red[(3 * 17 + r) * 64 + cc];
        P.mod[((size_t)(l * 17 + r)) * 6144 + col0 + cc] = s + P.ada_b[l * 6144 + col0 + cc];
      }
      __syncthreads();
    } else if (item < 384 + 256) {
      int e = (item - 384) * 256 + tid;
      int pos = e >> 5, i = e & 31;
      double inv = pow(10000.0, -2.0 * (double)i / 64.0);
      double ang = (double)pos * inv;
      P.ropeR[e * 2] = (float)cos(ang);
      P.ropeR[e * 2 + 1] = (float)sin(ang);
    } else {
      for (int e = tid; e < 64 * 16; e += 256) {
        int pos = e >> 4, i = e & 15;
        double ang = (double)pos * pow(10000.0, -2.0 * (double)i / 32.0);
        P.ropeA[e * 2] = (float)cos(ang); P.ropeA[e * 2 + 1] = (float)sin(ang);
      }
      for (int e = tid; e < 64 * 8; e += 256) {
        int pos = e >> 3, i = e & 7;
        double ang = (double)pos * pow(10000.0, -2.0 * (double)i / 16.0);
        P.ropeD[e * 2] = (float)cos(ang); P.ropeD[e * 2 + 1] = (float)sin(ang);
      }
      if (tid < NL) {
        const float* dl = P.diff_lambda + tid * 128;
        float s1 = 0.f, s2 = 0.f;
        for (int i = 0; i < 32; ++i) { s1 += dl[i] * dl[32 + i]; s2 += dl[64 + i] * dl[96 + i]; }
        float li = (float)(0.8 - 0.6 * exp(-0.3 * (double)tid));
        P.lamv[tid * 2] = expf(s1) - expf(s2) + li;
        P.lamv[tid * 2 + 1] = li;
      }
    }
  }
}

__device__ void phase_prep(const Params& P, int l, int mode, int bid, int nb, const int dummy = 0) {
  const int tid = opaque_tid();
  const int lane = tid & 63, wave = tid >> 6;
  const bool latent_only = (mode == 2) || (mode == 1 && l == NL - 1);
  const bool do_ln = !(mode == 0 && l == 0);
  const float* lg = P.post1_g; const float* lb = P.post1_b;
  if (mode == 0) { if (l > 0) { lg = P.post2_g + (l - 1) * D; lb = P.post2_b + (l - 1) * D; } }
  else if (mode == 1) { lg = P.post1_g + l * D; lb = P.post1_b + l * D; }
  else { lg = P.post2_g + (NL - 1) * D; lb = P.post2_b + (NL - 1) * D; }
  const int shofs = (mode == 0) ? 0 : 3 * D, scofs = shofs + D;
  const int mstep = nb * 4;
  int mn = bid * 4 + wave;
  while (mn < MALL && latent_only && (mn % TALL) < CTX) mn += mstep;
  float4 nv0 = make_float4(0.f, 0.f, 0.f, 0.f), nv1 = nv0, nv2 = nv0, nv3 = nv0;
  if (mn < MALL) {
    const int b = mn / TALL, t = mn - b * TALL; const bool isctx = t < CTX;
    const float* src = do_ln ? (isctx ? P.zctx + ((size_t)(b * CTX + t)) * D : P.out + ((size_t)(b * SEQ + t - CTX)) * D)
                             : (isctx ? P.ctx + ((size_t)(b * CTX + t)) * D : P.x + ((size_t)(b * SEQ + t - CTX)) * D);
    nv0 = *(const float4*)(src + lane * 4); nv1 = *(const float4*)(src + 256 + lane * 4); nv2 = *(const float4*)(src + 512 + lane * 4); nv3 = *(const float4*)(src + 768 + lane * 4);
  }
  while (mn < MALL) {
    const int m = mn;
    const int b = m / TALL, t = m - b * TALL;
    const bool isctx = t < CTX;
    float* xr = isctx ? P.zctx + ((size_t)(b * CTX + t)) * D : P.out + ((size_t)(b * SEQ + t - CTX)) * D;
    float4 v[4];
    v[0] = nv0; v[1] = nv1; v[2] = nv2; v[3] = nv3;
    mn += mstep;
    while (mn < MALL && latent_only && (mn % TALL) < CTX) mn += mstep;
    if (mn < MALL) {
      const int b2 = mn / TALL, t2 = mn - b2 * TALL; const bool c2 = t2 < CTX;
      const float* src = do_ln ? (c2 ? P.zctx + ((size_t)(b2 * CTX + t2)) * D : P.out + ((size_t)(b2 * SEQ + t2 - CTX)) * D)
                               : (c2 ? P.ctx + ((size_t)(b2 * CTX + t2)) * D : P.x + ((size_t)(b2 * SEQ + t2 - CTX)) * D);
      nv0 = *(const float4*)(src + lane * 4); nv1 = *(const float4*)(src + 256 + lane * 4); nv2 = *(const float4*)(src + 512 + lane * 4); nv3 = *(const float4*)(src + 768 + lane * 4);
    }
    float4 v0s[4];
    if (dummy) {
#pragma unroll
      for (int i = 0; i < 4; ++i) v0s[i] = v[i];
    }
    if (do_ln) {
      float s = 0.f;
#pragma unroll
      for (int i = 0; i < 4; ++i) s += v[i].x + v[i].y + v[i].z + v[i].w;
      const float mean = wave_sum(s) * (1.f / 1024.f);
      float q = 0.f;
#pragma unroll
      for (int i = 0; i < 4; ++i) { v[i].x -= mean; v[i].y -= mean; v[i].z -= mean; v[i].w -= mean; q += v[i].x * v[i].x + v[i].y * v[i].y + v[i].z * v[i].z + v[i].w * v[i].w; }
      const float rstd = rsqrtf(wave_sum(q) * (1.f / 1024.f) + 1e-5f);
      if (mode != 2 && lane == 0) *(float2*)(P.stats + (size_t)m * 2) = make_float2(mean, rstd);
#pragma unroll
      for (int i = 0; i < 4; ++i) {
        float4 g4 = *(const float4*)(lg + i * 256 + lane * 4), b4 = *(const float4*)(lb + i * 256 + lane * 4);
        v[i].x = v[i].x * rstd * g4.x + b4.x; v[i].y = v[i].y * rstd * g4.y + b4.y; v[i].z = v[i].z * rstd * g4.z + b4.z; v[i].w = v[i].w * rstd * g4.w + b4.w;
      }
    }
    if (dummy) {
#pragma unroll
      for (int i = 0; i < 4; ++i) { asm volatile("" :: "v"(v[i].x), "v"(v[i].y), "v"(v[i].z), "v"(v[i].w)); v[i] = v0s[i]; }
    }
    if (mode == 2 || dummy) {
#pragma unroll
      for (int i = 0; i < 4; ++i) *(float4*)(xr + i * 256 + lane * 4) = v[i];
    }
    if (mode != 2) {
      const int modrow = isctx ? 16 : b;
      const float* md = P.mod + ((size_t)(l * 17 + modrow)) * 6144;
#pragma unroll
      for (int i = 0; i < 4; ++i) {
        float4 sh = *(const float4*)(md + shofs + i * 256 + lane * 4), sc = *(const float4*)(md + scofs + i * 256 + lane * 4);
        uint2 o;
        o.x = pack2(v[i].x * (1.f + sc.x) + sh.x, v[i].y * (1.f + sc.y) + sh.y);
        o.y = pack2(v[i].z * (1.f + sc.z) + sh.z, v[i].w * (1.f + sc.w) + sh.w);
        *(uint2*)(P.abuf + (size_t)m * D + i * 256 + lane * 4) = o;
      }
    }
  }
}

enum { EPI_P = 0, EPI_RES1 = 1, EPI_RES2 = 2, EPI_SWIGLU = 3 };
template <int EPI, bool latent_only>
__device__ void phase_gemm(const Params& P, int l, const u16* __restrict__ A, const u16* __restrict__ Bt, const int K,
                           const int NT, unsigned char* smem, int bid, int nb, const int dummy = 0) {
  u16* sA = (u16*)smem;
  u16* sB = sA + 2 * 128 * 72;
  const int tid = opaque_tid(), lane = tid & 63, wave = tid >> 6, r = lane & 31, h = lane >> 5, wm = wave >> 1, wn = wave & 1;
  const int MT = latent_only ? 256 : 288;
  const int total = MT * NT, KT = K >> 6;
  const int lrow = tid >> 3, lkc = tid & 7;
  const bool swz = ((nb & 7) == 0);
  const int qstart = swz ? (bid >> 3) : bid, qstep = swz ? (nb >> 3) : nb, qtotal = swz ? (MT >> 3) * NT : total;
  for (int q = qstart; q < qtotal; q += qstep) {
    int mq, nt;
    if (swz) {
      const int MTX = MT >> 3, per_sr = 8 * NT;
      const int sr = q / per_sr, rem = q - sr * per_sr;
      const int gm = min(8, MTX - sr * 8);
      nt = rem / gm; mq = sr * 8 + (rem - nt * gm);
    } else { mq = q / NT; nt = q - mq * NT; }
    const int mi_ = swz ? (mq * 8 + (bid & 7)) : mq;
    const int mt = latent_only ? ((mi_ >> 4) * 18 + 2 + (mi_ & 15)) : mi_;
    const int m0 = mt * 128, n0 = nt * 128;
    f32x16 acc[2][2];
#pragma unroll
    for (int a = 0; a < 2; ++a)
#pragma unroll
      for (int b = 0; b < 2; ++b)
#pragma unroll
        for (int i = 0; i < 16; ++i) acc[a][b][i] = 0.f;
    const u16* Ag = A + (size_t)(m0 + lrow) * K + lkc * 8;
    const u16* Bg = Bt + (size_t)(n0 + lrow) * K + lkc * 8;
    const size_t K32 = (size_t)32 * K;
    uint4 xa0, xa1, xa2, xa3, xb0, xb1, xb2, xb3;
    uint4 ya0, ya1, ya2, ya3, yb0, yb1, yb2, yb3;
#define G_LOAD(S, kt_) { const int ko_ = (kt_) * 64; \
      S##a0 = *(const uint4*)(Ag + ko_); S##a1 = *(const uint4*)(Ag + K32 + ko_); S##a2 = *(const uint4*)(Ag + 2 * K32 + ko_); S##a3 = *(const uint4*)(Ag + 3 * K32 + ko_); \
      S##b0 = *(const uint4*)(Bg + ko_); S##b1 = *(const uint4*)(Bg + K32 + ko_); S##b2 = *(const uint4*)(Bg + 2 * K32 + ko_); S##b3 = *(const uint4*)(Bg + 3 * K32 + ko_); }
#define G_STORE(S, st_) { u16* sa_ = sA + (st_) * (128 * 72) + lrow * 72 + lkc * 8; u16* sb_ = sB + (st_) * (128 * 72) + lrow * 72 + lkc * 8; \
      *(uint4*)(sa_) = S##a0; *(uint4*)(sa_ + 32 * 72) = S##a1; *(uint4*)(sa_ + 64 * 72) = S##a2; *(uint4*)(sa_ + 96 * 72) = S##a3; \
      *(uint4*)(sb_) = S##b0; *(uint4*)(sb_ + 32 * 72) = S##b1; *(uint4*)(sb_ + 64 * 72) = S##b2; *(uint4*)(sb_ + 96 * 72) = S##b3; }
#define G_COMPUTE(st_) { \
      const u16* a_ = sA + (st_) * (128 * 72) + (wm * 64 + r) * 72 + h * 8; \
      const u16* b_ = sB + (st_) * (128 * 72) + (wn * 64 + r) * 72 + h * 8; \
      __builtin_amdgcn_s_setprio(1); \
      _Pragma("unroll") for (int ks = 0; ks < 4; ++ks) { \
        bf16x8 a0 = *(const bf16x8*)(a_ + ks * 16), a1 = *(const bf16x8*)(a_ + 32 * 72 + ks * 16); \
        bf16x8 b0 = *(const bf16x8*)(b_ + ks * 16), b1 = *(const bf16x8*)(b_ + 32 * 72 + ks * 16); \
        acc[0][0] = MFMA32(a0, b0, acc[0][0]); acc[0][1] = MFMA32(a0, b1, acc[0][1]); \
        acc[1][0] = MFMA32(a1, b0, acc[1][0]); acc[1][1] = MFMA32(a1, b1, acc[1][1]); } \
      __builtin_amdgcn_s_setprio(0); }
    G_LOAD(x, 0);
    G_STORE(x, 0);
    __syncthreads();
    if (KT > 1) G_LOAD(x, 1);
    for (int kt = 0; kt < KT; kt += 2) {
      if (kt + 2 < KT && dummy != 2) G_LOAD(y, kt + 2);
      G_COMPUTE(0);
      if (kt + 1 < KT && dummy != 2) G_STORE(x, 1);
      __syncthreads();
      if (kt + 1 >= KT) break;
      if (kt + 3 < KT && dummy != 2) G_LOAD(x, kt + 3);
      G_COMPUTE(1);
      if (kt + 2 < KT && dummy != 2) G_STORE(y, 0);
      __syncthreads();
    }
#undef G_LOAD
#undef G_STORE
#undef G_COMPUTE
    int m0e = m0, n0e = n0;
    asm volatile("" : "+s"(m0e), "+s"(n0e));
    int rb = wm * 64 + 4 * h, cb = wn * 64 + r;
    asm volatile("" : "+v"(rb), "+v"(cb));
    if (EPI == EPI_P) {
      const int wc0 = n0e + (cb & 64);
      int vh = -1;
      if (wc0 >= 1344 && wc0 < 1472) vh = (wc0 - 1344) >> 6;
      else if (wc0 >= 1984 && wc0 < 2240) vh = 2 + ((wc0 - 1984) >> 6);
      else if (wc0 >= 2752 && wc0 < 3008) vh = 6 + ((wc0 - 2752) >> 6);
      if (vh >= 0) {
        const int bb = m0e / TALL, t0 = m0e - bb * TALL;
#pragma unroll
        for (int mi = 0; mi < 2; ++mi)
#pragma unroll
          for (int ni = 0; ni < 2; ++ni)
#pragma unroll
            for (int g4 = 0; g4 < 4; ++g4) {
              const int d = ni * 32 + (cb & 31);
              const int tkn = t0 + (rb & 64) + mi * 32 + 8 * g4 + (rb & 63);
              const int q4 = (tkn >> 2) & 3;
              const int tk = (tkn & ~15) | ((q4 == 1 ? 2 : (q4 == 2 ? 1 : q4)) << 2);
              uint2 w;
              w.x = pack2(acc[mi][ni][4 * g4], acc[mi][ni][4 * g4 + 1]);
              w.y = pack2(acc[mi][ni][4 * g4 + 2], acc[mi][ni][4 * g4 + 3]);
              *(uint2*)(P.vt + ((size_t)((bb * 10 + vh) * 64 + d)) * TALL + tk) = w;
            }
      } else
#pragma unroll
      for (int mi = 0; mi < 2; ++mi)
#pragma unroll
        for (int ni = 0; ni < 2; ++ni) {
          const int col = n0e + cb + ni * 32;
          if (col < INW && (dummy < 2 || acc[mi][ni][0] == 12345.678f)) {
            const bool odd = (cb & 1) != 0;
#pragma unroll
            for (int i = 0; i < 16; i += 2) {
              const float a = acc[mi][ni][i], b2 = acc[mi][ni][i + 1];
              const float recv = dpp_f(odd ? a : b2, 0);
              const int row = m0e + rb + mi * 32 + (i & 3) + 8 * (i >> 2) + (odd ? 1 : 0);
              const unsigned w = odd ? pack2(recv, b2) : pack2(a, recv);
              __builtin_nontemporal_store(w, (unsigned*)(P.pbuf + (size_t)row * INW + (col & ~1)));
            }
          }
        }
    } else if (EPI == EPI_RES1 || EPI == EPI_RES2) {
      const int b = m0e / TALL, t0 = m0e - b * TALL;
      const bool isctx = t0 < CTX;
      float* xb = isctx ? P.zctx + ((size_t)(b * CTX + t0)) * D : P.out + ((size_t)(b * SEQ + t0 - CTX)) * D;
      const float* g = P.mod + ((size_t)(l * 17 + (isctx ? 16 : b))) * 6144 + (EPI == EPI_RES1 ? 2 * D : 5 * D);
      const float* xs = (EPI == EPI_RES1 && l == 0) ? (isctx ? P.ctx + ((size_t)(b * CTX + t0)) * D : P.x + ((size_t)(b * SEQ + t0 - CTX)) * D) : xb;
      const float gv0 = g[n0e + cb], gv1 = g[n0e + cb + 32];
      const bool haveln = !(EPI == EPI_RES1 && l == 0);
      const float* lgp = (EPI == EPI_RES1) ? P.post2_g + (size_t)(l > 0 ? l - 1 : 0) * D : P.post1_g + (size_t)l * D;
      const float* lbp = (EPI == EPI_RES1) ? P.post2_b + (size_t)(l > 0 ? l - 1 : 0) * D : P.post1_b + (size_t)l * D;
      const float lg0 = lgp[n0e + cb], lg1 = lgp[n0e + cb + 32], lb0 = lbp[n0e + cb], lb1 = lbp[n0e + cb + 32];
#pragma unroll
      for (int mi = 0; mi < 2; ++mi) {
        float xo[2][16];
        float2 ms[16];
#pragma unroll
        for (int ni = 0; ni < 2; ++ni)
#pragma unroll
          for (int i = 0; i < 16; ++i)
            xo[ni][i] = xs[(size_t)(rb + mi * 32 + (i & 3) + 8 * (i >> 2)) * D + n0e + cb + ni * 32];
#pragma unroll
        for (int i = 0; i < 16; ++i)
          ms[i] = haveln ? *(const float2*)(P.stats + (size_t)(m0e + rb + mi * 32 + (i & 3) + 8 * (i >> 2)) * 2) : make_float2(0.f, 1.f);
        if (haveln) {
#pragma unroll
          for (int ni = 0; ni < 2; ++ni)
#pragma unroll
            for (int i = 0; i < 16; ++i) xo[ni][i] = (xo[ni][i] - ms[i].x) * ms[i].y * (ni ? lg1 : lg0) + (ni ? lb1 : lb0);
        }
#pragma unroll
        for (int ni = 0; ni < 2; ++ni)
#pragma unroll
          for (int i = 0; i < 16; ++i) {
            float* px = xb + (size_t)(rb + mi * 32 + (i & 3) + 8 * (i >> 2)) * D + n0e + cb + ni * 32;
            if (dummy == 3) { if (acc[mi][ni][i] == 12345.678f) *px = 0.f; }
            else {
              float xn = ALPHA * xo[ni][i] + (ni ? gv1 : gv0) * acc[mi][ni][i];
              if (dummy) { asm volatile("" :: "v"(xn)); xn = xo[ni][i]; }
              *px = xn;
            }
          }
      }
    } else {
      const int hb = (n0e >> 7) * 64 + (cb >> 6) * 32 + (cb & 31);
      const bool odd = (cb & 1) != 0;
#pragma unroll
      for (int mi = 0; mi < 2; ++mi)
#pragma unroll
        for (int i = 0; i < 16; i += 2) {
          const float u0 = acc[mi][0][i], g0 = acc[mi][1][i], u1 = acc[mi][0][i + 1], g1 = acc[mi][1][i + 1];
          const float a = u0 * __builtin_amdgcn_rcpf(1.f + __expf(-u0)) * g0, b2 = u1 * __builtin_amdgcn_rcpf(1.f + __expf(-u1)) * g1;
          const float recv = dpp_f(odd ? a : b2, 0);
          const int row = m0e + rb + mi * 32 + (i & 3) + 8 * (i >> 2) + (odd ? 1 : 0);
          const unsigned w = odd ? pack2(recv, b2) : pack2(a, recv);
          __builtin_nontemporal_store(w, (unsigned*)(P.pbuf + (size_t)row * DFF + (hb & ~1)));
        }
    }
  }
}

__device__ void phase_attnprep(const Params& P, int l, unsigned char* smem, int bid, int nb, const int dummy = 0) {
  const int tid = opaque_tid(), lane = tid & 63, wave = tid >> 6;
  for (int m = bid * 4 + wave; m < MALL; m += nb * 4) {
    const int b = m / TALL, t = m - b * TALL;
    const bool isctx = t < CTX;
    const int tp = t - CTX, rowp = tp >> 6, colp = tp & 63;
    u16* pr = P.pbuf + (size_t)m * INW;
    float xv[22];
#pragma unroll
    for (int ch = 0; ch < 22; ++ch) {
      const int col = ch < 4 ? 960 + ch * 64 : (ch < 6 ? 1216 + (ch - 4) * 64 : (ch < 10 ? 1472 + (ch - 6) * 64 : (ch < 14 ? 1728 + (ch - 10) * 64 : (ch < 18 ? 2240 + (ch - 14) * 64 : 2496 + (ch - 18) * 64))));
      xv[ch] = bf2f(pr[col + lane]);
    }
    float csA = 1.f, snA = 0.f, csD = 1.f, snD = 0.f, csR = 1.f, snR = 0.f;
    if (!isctx) {
      { const int e = lane & 31, pos = (lane >> 5) ? colp : rowp, i = e & 15; csA = P.ropeA[(pos * 16 + i) * 2]; snA = P.ropeA[(pos * 16 + i) * 2 + 1]; if (e < 16) snA = -snA; }
      { const int e = lane & 15, pos = ((lane >> 4) & 1) ? colp : rowp, i = e & 7; csD = P.ropeD[(pos * 8 + i) * 2]; snD = P.ropeD[(pos * 8 + i) * 2 + 1]; if (e < 8) snD = -snD; }
      { const int i = lane & 31; csR = P.ropeR[(tp * 32 + i) * 2]; snR = P.ropeR[(tp * 32 + i) * 2 + 1]; if (lane < 32) snR = -snR; }
    }
    const float gq = P.gqa_q_norm[l * 64 + lane], gk = P.gqa_k_norm[l * 64 + lane];
#pragma unroll
    for (int ch = 0; ch < 22; ++ch) {
      const int col = ch < 4 ? 960 + ch * 64 : (ch < 6 ? 1216 + (ch - 4) * 64 : (ch < 10 ? 1472 + (ch - 6) * 64 : (ch < 14 ? 1728 + (ch - 10) * 64 : (ch < 18 ? 2240 + (ch - 14) * 64 : 2496 + (ch - 18) * 64))));
      float x = xv[ch];
      if (ch < 6) {
        const float ss = wave_sum(x * x);
        x = x * rsqrtf(ss * (1.f / 64.f) + 1e-6f) * (ch < 4 ? gq : gk);
        const float partner = __shfl_xor(x, 16);
        x = x * csA + partner * snA;
        if (ch < 4) x *= 0.125f * LOG2E;
      } else if (ch < 14) {
        const float partner = __shfl_xor(x, 8);
        x = x * csD + partner * snD;
        if (ch < 10) x *= 0.17677669529663687f * LOG2E;
      } else {
        const float partner = __shfl_xor(x, 32);
        x = x * csR + partner * snR;
        if (ch >= 18) x *= 0.125f;
      }
      if (dummy) { asm volatile("" :: "v"(x)); x = xv[ch]; }
      pr[col + lane] = f2bf(x);
    }
  }
}

__device__ void scan_item(const Params& P, int l, int item, unsigned char* smem, const int pm = 0) {
  float* prep = (float*)smem;
  u16* raw = (u16*)(smem + 49152);
  u16* twb = (u16*)(smem + 49152 + 17408);
  u16* tab = twb + 32 * 40;
  float* ybuf = (float*)(smem + 49152 + 17408 + 8192);
  const int tid = opaque_tid(), lane = tid & 63, wave = tid >> 6;
  __builtin_amdgcn_s_setprio(3);
  const int dir = item >> 7, b = (item >> 3) & 15, hh = (item >> 1) & 3, hf = item & 1;
  const int c = tid;
  int pcol;
  if (c < 64) pcol = hh * 64 + c; else if (c < 128) pcol = 256 + hh * 64 + (c - 64); else if (c < 192) pcol = 512 + hh * 64 + (c - 128);
  else if (c < 224) pcol = 768 + dir * 32 + (c - 192); else pcol = 832 + dir * 32 + (c - 224);
  const float mu = P.rwkv_mu[l * 960 + pcol];
  const int kB = tid & 63, tg = tid >> 6;
  const int wv = __builtin_amdgcn_readfirstlane(wave);
  bf16x8 bfr0, bfr1;
  {
    const float* up = ((wv >> 1) ? P.rwkv_a_up : P.rwkv_w_up) + ((size_t)((l * 2 + dir) * 32)) * 256 + hh * 64 + (wv & 1) * 32 + (lane & 31);
    const int hq = lane >> 5;
    u32x4 t0, t1;
#pragma unroll
    for (int jj = 0; jj < 4; ++jj) {
      t0[jj] = pack2(up[(size_t)(8 * hq + 2 * jj) * 256], up[(size_t)(8 * hq + 2 * jj + 1) * 256]);
      t1[jj] = pack2(up[(size_t)(16 + 8 * hq + 2 * jj) * 256], up[(size_t)(16 + 8 * hq + 2 * jj + 1) * 256]);
    }
    bfr0 = __builtin_bit_cast(bf16x8, t0); bfr1 = __builtin_bit_cast(bf16x8, t1);
  }
  const float w0 = P.rwkv_w0[(l * 2 + dir) * 256 + hh * 64 + kB], a0 = P.rwkv_a0[(l * 2 + dir) * 256 + hh * 64 + kB];
  const float ka = P.rwkv_k_a[l * 256 + hh * 64 + kB], rk = P.rwkv_r_k[(l * 4 + hh) * 64 + kB];
  const float kkwB = P.rwkv_k_k[l * 256 + hh * 64 + kB];
  const int vec = tid & 31;
  int vcol;
  if (vec < 8) vcol = hh * 64 + vec * 8; else if (vec < 16) vcol = 256 + hh * 64 + (vec - 8) * 8; else if (vec < 24) vcol = 512 + hh * 64 + (vec - 16) * 8;
  else if (vec < 28) vcol = 768 + dir * 32 + (vec - 24) * 8; else vcol = 832 + dir * 32 + (vec - 28) * 8;
  const u16* pb = P.pbuf + (size_t)(b * TALL) * INW + vcol;
  f32v2 S0 = {0.f, 0.f}, S1 = S0, S2 = S0, S3 = S0;
  const int rowl = wave * 8 + (lane >> 3), ks = lane & 7;
  uint4 rg0 = make_uint4(0, 0, 0, 0), rg1 = rg0, rg2 = rg0, rg3 = rg0, rg4 = rg0;

  for (int ch = -1; ch < 72; ++ch) {
    const int nx = ch + 1;
    const bool more = nx < 72;
    if (more) {
      const int n0 = nx * 32; const bool cx = n0 < 256;
      const int tlo = dir ? (cx ? 224 - n0 : 2528 - n0) : n0;
      const int slo = cx ? 0 : 256, shi = cx ? 256 : 2304;
      rg0 = *(const uint4*)(pb + (size_t)(tlo + (tid >> 5)) * INW);
      rg1 = *(const uint4*)(pb + (size_t)(tlo + (tid >> 5) + 8) * INW);
      rg2 = *(const uint4*)(pb + (size_t)(tlo + (tid >> 5) + 16) * INW);
      rg3 = *(const uint4*)(pb + (size_t)(tlo + (tid >> 5) + 24) * INW);
      rg4 = make_uint4(0, 0, 0, 0);
      if (tid < 64) { const int tok = (tid >> 5) ? tlo + 32 : tlo - 1; if (tok >= slo && tok < shi) rg4 = *(const uint4*)(pb + (size_t)tok * INW); }
    }
    if (ch >= 0 && !(pm & 1)) {
      {
        const float* psb = prep + ks * 8;
        const float* pvb = prep + 320 + hf * 32 + rowl;
        float4 nap0 = *(const float4*)(psb), nap1 = *(const float4*)(psb + 4);
        float4 nw0 = *(const float4*)(psb + 64), nw1 = *(const float4*)(psb + 68);
        float4 nbp0 = *(const float4*)(psb + 128), nbp1 = *(const float4*)(psb + 132);
        float4 nkd0 = *(const float4*)(psb + 192), nkd1 = *(const float4*)(psb + 196);
        float4 nr0 = *(const float4*)(psb + 256), nr1 = *(const float4*)(psb + 260);
        float nvv = pvb[0];
#pragma unroll 2
        for (int step = 0; step < 32; ++step) {
          const float4 ap0 = nap0, ap1 = nap1, w0v = nw0, w1v = nw1, bp0 = nbp0, bp1 = nbp1, kd0 = nkd0, kd1 = nkd1, r0 = nr0, r1 = nr1;
          const float vv = nvv;
          {
            const int nxs = (step < 31) ? step + 1 : 31;
            const float* ps = psb + nxs * 384;
            nap0 = *(const float4*)(ps); nap1 = *(const float4*)(ps + 4);
            nw0 = *(const float4*)(ps + 64); nw1 = *(const float4*)(ps + 68);
            nbp0 = *(const float4*)(ps + 128); nbp1 = *(const float4*)(ps + 132);
            nkd0 = *(const float4*)(ps + 192); nkd1 = *(const float4*)(ps + 196);
            nr0 = *(const float4*)(ps + 256); nr1 = *(const float4*)(ps + 260);
            nvv = pvb[nxs * 384];
          }
          f32v2 t = S0 * (f32v2){ap0.x, ap0.y};
          t = S1 * (f32v2){ap0.z, ap0.w} + t;
          t = S2 * (f32v2){ap1.x, ap1.y} + t;
          t = S3 * (f32v2){ap1.z, ap1.w} + t;
          const float sa = reduce8(t.x + t.y);
          const f32v2 sa2 = {sa, sa}, vv2 = {vv, vv};
          S0 = S0 * (f32v2){w0v.x, w0v.y} + (sa2 * (f32v2){bp0.x, bp0.y} + vv2 * (f32v2){kd0.x, kd0.y});
          S1 = S1 * (f32v2){w0v.z, w0v.w} + (sa2 * (f32v2){bp0.z, bp0.w} + vv2 * (f32v2){kd0.z, kd0.w});
          S2 = S2 * (f32v2){w1v.x, w1v.y} + (sa2 * (f32v2){bp1.x, bp1.y} + vv2 * (f32v2){kd1.x, kd1.y});
          S3 = S3 * (f32v2){w1v.z, w1v.w} + (sa2 * (f32v2){bp1.z, bp1.w} + vv2 * (f32v2){kd1.z, kd1.w});
          f32v2 u = S0 * (f32v2){r0.x, r0.y};
          u = S1 * (f32v2){r0.z, r0.w} + u;
          u = S2 * (f32v2){r1.x, r1.y} + u;
          u = S3 * (f32v2){r1.z, r1.w} + u;
          const float y = reduce8(u.x + u.y);
          if (ks == 0) ybuf[step * 32 + rowl] = y;
        }
      }
      __syncthreads();
      {
        const int step = tid >> 3, q = tid & 7;
        const int n = ch * 32 + step;
        const int tok = dir ? (n < 256 ? 255 - n : 2559 - n) : n;
        float4 yv = *(const float4*)(ybuf + step * 32 + q * 4);
        if (!(pm & 8)) { uint2 w; w.x = pack2(yv.x, yv.y); w.y = pack2(yv.z, yv.w); *(uint2*)(P.yd + ((size_t)(dir * MALL + b * TALL + tok)) * 256 + hh * 64 + hf * 32 + q * 4) = w; }
      }
    }
    if (more) {
      *(uint4*)(raw + (1 + (tid >> 5)) * 256 + vec * 8) = rg0;
      *(uint4*)(raw + (9 + (tid >> 5)) * 256 + vec * 8) = rg1;
      *(uint4*)(raw + (17 + (tid >> 5)) * 256 + vec * 8) = rg2;
      *(uint4*)(raw + (25 + (tid >> 5)) * 256 + vec * 8) = rg3;
      if (tid < 64) *(uint4*)(raw + ((tid >> 5) ? 33 : 0) * 256 + vec * 8) = rg4;
      __syncthreads();
      if (!(pm & 2)) {
        float pv[34];
#pragma unroll
        for (int j = 0; j < 34; ++j) pv[j] = bf2f(raw[j * 256 + c]);
        if (wv < 3) {
          float* pdst = prep + (wv == 0 ? 256 + c : (wv == 1 ? 192 + (c - 64) : 320 + (c - 128)));
#pragma unroll
          for (int j = 0; j < 32; ++j) {
            const float psv = pv[j + 1] + mu * (0.5f * (pv[j] + pv[j + 2]) - pv[j + 1]);
            pdst[(dir ? 31 - j : j) * 384] = psv;
          }
        } else {
          u16* tdst = ((c < 224) ? twb : tab) + ((c - 192) & 31);
#pragma unroll
          for (int j = 0; j < 32; ++j) {
            const float psv = pv[j + 1] + mu * (0.5f * (pv[j] + pv[j + 2]) - pv[j + 1]);
            const float th = 1.f - 2.f * __builtin_amdgcn_rcpf(__expf(2.f * psv) + 1.f);
            tdst[(dir ? 31 - j : j) * 40] = f2bf((c < 224) ? th : psv);
          }
        }
      }
      __syncthreads();
      if (!(pm & 4)) {
        const int r = lane & 31, hq = lane >> 5;
        const u16* asrc = ((wv >> 1) ? tab : twb) + r * 40 + 8 * hq;
        const bf16x8 af0 = *(const bf16x8*)(asrc), af1 = *(const bf16x8*)(asrc + 16);
        f32x16 accl;
#pragma unroll
        for (int i = 0; i < 16; ++i) accl[i] = 0.f;
        accl = MFMA32(af0, bfr0, accl);
        accl = MFMA32(af1, bfr1, accl);
        float* odst = prep + ((wv >> 1) ? 128 : 64) + (wv & 1) * 32 + r;
#pragma unroll
        for (int i = 0; i < 16; ++i) odst[crow(i, hq) * 384] = accl[i];
      }
      __syncthreads();
      if (!(pm & 4)) {
        const int n0 = nx * 32;
#pragma unroll 2
        for (int s = 0; s < 8; ++s) {
          const int step = tg * 8 + s;
          float* pp = prep + step * 384;
          const float wacc = w0 + pp[64 + kB], aacc = a0 + pp[128 + kB];
          const float sg = __builtin_amdgcn_rcpf(1.f + __expf(-wacc));
          const float decay = __expf(-0.6065306597126334f * sg);
          const float av = __builtin_amdgcn_rcpf(1.f + __expf(-aacc));
          const float ksv = pp[192 + kB];
          const float xk = ksv * kkwB;
          const float kk = xk * rsqrtf(fmaxf(wave_sum(xk * xk), 1e-24f));
          const float kd = ksv * (1.f + (av - 1.f) * ka);
          pp[64 + kB] = decay; pp[192 + kB] = kd; pp[128 + kB] = kk * av; pp[kB] = -kk;
          const float cs = wave_sum(pp[256 + kB] * kd * rk);
          if (lane == 0 && hf == 0 && !(pm & 8)) {
            const int n = n0 + step;
            const int tok = dir ? (n < 256 ? 255 - n : 2559 - n) : n;
            P.cbuf[((size_t)(dir * MALL + b * TALL + tok)) * 4 + hh] = cs;
          }
        }
      }
    }
    __syncthreads();
  }
  __builtin_amdgcn_s_setprio(0);
}

template <int KIND>
__device__ void attn_item(const Params& P, int l, int b, int hh, int qb, bool isctx, unsigned char* smem) {
  constexpr int NMAP = (KIND == 1) ? 2 : 1;
  constexpr int NKS = (KIND == 1) ? 2 : 4;
  u16* sK = (u16*)smem;
  u16* sV = sK + 2 * 64 * 72;
  float* stash = (float*)(smem + 4 * 64 * 72 * 2);
  const int tid = opaque_tid(), lane = tid & 63, wave = tid >> 6, r = lane & 31, h = lane >> 5;
  int qcol, kcol, vh, ycol;
  if (KIND == 0) { qcol = 960 + hh * 64; kcol = 1216 + (hh >> 1) * 64; vh = hh >> 1; ycol = 256 + hh * 64; }
  else if (KIND == 1) { qcol = 1472 + hh * 64; kcol = 1728 + hh * 64; vh = 2 + hh; ycol = 512 + hh * 64; }
  else { qcol = 2240 + hh * 64; kcol = 2496 + hh * 64; vh = 6 + hh; ycol = 768 + hh * 64; }
  const int iq = qb * 128 + wave * 32 + r;
  const int tq = b * TALL + (isctx ? 0 : CTX) + iq;
  const int ntiles = isctx ? 4 : 36;
  float lgf = 0.f, lgb = 0.f;
  if (KIND == 2) { lgf = log2f(1.f - exp2f(-5.f - (float)hh)); lgb = log2f(1.f - exp2f(-5.f - (float)(3 - hh))); }
  float cf[16], cb[16], ckf = 1.f, ckb = 1.f;
  if (KIND == 2) {
#pragma unroll
    for (int i = 0; i < 16; ++i) {
      const float o_ = (float)crow(i, h);
      cf[i] = __builtin_amdgcn_exp2f(-o_ * lgf);
      cb[i] = __builtin_amdgcn_exp2f(o_ * lgb);
    }
    ckf = __builtin_amdgcn_exp2f(-32.f * lgf); ckb = __builtin_amdgcn_exp2f(32.f * lgb);
  }
  const int q0w = qb * 128 + wave * 32;
  const int lrow = tid >> 3, lvec = tid & 7;
  const u16* Kg = P.pbuf + (size_t)(b * TALL + lrow) * INW + kcol + lvec * 8;
  const u16* Vg = P.vt + ((size_t)((b * 10 + vh) * 64 + lrow)) * TALL + lvec * 8;
  float o[2][16];
  {
    bf16x8 qf[NMAP][NKS];
    f32x16 O[NMAP][2];
    float mrun[NMAP], lsum[NMAP];
#pragma unroll
    for (int mp = 0; mp < NMAP; ++mp) {
      mrun[mp] = 0.f; lsum[mp] = 0.f;
#pragma unroll
      for (int ks = 0; ks < NKS; ++ks) qf[mp][ks] = *(const bf16x8*)(P.pbuf + (size_t)tq * INW + qcol + mp * 32 + ks * 16 + h * 8);
#pragma unroll
      for (int dt = 0; dt < 2; ++dt)
#pragma unroll
        for (int i = 0; i < 16; ++i) O[mp][dt][i] = 0.f;
    }
    uint4 xk0, xk1, xv0, xv1;
#define ATT_LOAD(S, t_) { S##k0 = *(const uint4*)(Kg + (size_t)((t_) * 64) * INW); S##k1 = *(const uint4*)(Kg + (size_t)((t_) * 64 + 32) * INW); \
      S##v0 = *(const uint4*)(Vg + (t_) * 64); S##v1 = *(const uint4*)(Vg + (size_t)32 * TALL + (t_) * 64); }
#define ATT_STORE(S, st_) { u16* k2 = sK + (st_) * (64 * 72); u16* v2 = sV + (st_) * (64 * 72); \
      *(uint4*)(k2 + lrow * 72 + lvec * 8) = S##k0; *(uint4*)(k2 + (lrow + 32) * 72 + lvec * 8) = S##k1; \
      *(uint4*)(v2 + lrow * 72 + lvec * 8) = S##v0; *(uint4*)(v2 + (lrow + 32) * 72 + lvec * 8) = S##v1; }
#define ATT_COMPUTE(t_, st_) { \
      const int t = (t_); \
      const u16* k_ = sK + (st_) * (64 * 72); \
      const u16* v_ = sV + (st_) * (64 * 72); \
      _Pragma("unroll") for (int mp = 0; mp < NMAP; ++mp) { \
      f32x16 st[2]; \
      const float sinit = (KIND != 2 && t > 0) ? -mrun[mp] : 0.f;     \
      _Pragma("unroll") for (int kt = 0; kt < 2; ++kt) { \
        _Pragma("unroll") for (int i = 0; i < 16; ++i) st[kt][i] = sinit; \
        _Pragma("unroll") for (int ks = 0; ks < NKS; ++ks) { \
          bf16x8 kf = *(const bf16x8*)(k_ + (kt * 32 + r) * 72 + mp * 32 + ks * 16 + h * 8); \
          st[kt] = MFMA32(kf, qf[mp][ks], st[kt]); \
        } \
      } \
      int rmode = 0; float rff = 0.f, rbb = 0.f; \
      if (KIND == 2) { \
        const int kb = t * 64 - (isctx ? 0 : 256); \
        if (!isctx && t < 4) { rmode = 3; rff = __builtin_amdgcn_exp2f((float)(iq - kb) * lgf); rbb = __builtin_amdgcn_exp2f((float)(2048 - iq + t * 64) * lgb); } \
        else if (kb + 63 < q0w) { rmode = 1; rff = __builtin_amdgcn_exp2f((float)(iq - kb) * lgf); } \
        else if (kb > q0w + 31) { rmode = 2; rbb = __builtin_amdgcn_exp2f((float)(kb - iq) * lgb); } \
      } \
      if (KIND != 2) { \
        float mx = st[0][0]; \
        _Pragma("unroll") for (int kt = 0; kt < 2; ++kt) \
          _Pragma("unroll") for (int i = 0; i < 16; ++i) mx = fmaxf(mx, st[kt][i]); \
        mx = xhalf_max(mx); \
        if (t == 0) {                        \
          mrun[mp] = mx; \
          _Pragma("unroll") for (int kt = 0; kt < 2; ++kt) \
            _Pragma("unroll") for (int i = 0; i < 16; ++i) st[kt][i] -= mx; \
        } else if (__builtin_amdgcn_ballot_w64(mx > 8.f) != 0ull) {     \
          const float delta = fmaxf(mx, 0.f); \
          const float alpha = __builtin_amdgcn_exp2f(-delta); \
          mrun[mp] += delta; \
          lsum[mp] *= alpha; \
          _Pragma("unroll") for (int kt = 0; kt < 2; ++kt) \
            _Pragma("unroll") for (int i = 0; i < 16; ++i) st[kt][i] -= delta; \
          _Pragma("unroll") for (int dt = 0; dt < 2; ++dt) \
            _Pragma("unroll") for (int i = 0; i < 16; ++i) O[mp][dt][i] *= alpha; \
        } \
      } \
      _Pragma("unroll") for (int kt = 0; kt < 2; ++kt) { \
        if (KIND != 2) { \
          f32v2 ps2 = {0.f, 0.f}; \
          _Pragma("unroll") for (int i = 0; i < 16; i += 2) { \
            const float p0 = __builtin_amdgcn_exp2f(st[kt][i]), p1 = __builtin_amdgcn_exp2f(st[kt][i + 1]); \
            st[kt][i] = p0; st[kt][i + 1] = p1; ps2 += (f32v2){p0, p1}; } \
          lsum[mp] += ps2.x + ps2.y; \
        } else if (rmode != 0) { \
          const float rf_ = kt ? rff * ckf : rff, rb_ = kt ? rbb * ckb : rbb; \
          _Pragma("unroll") for (int i = 0; i < 16; ++i) st[kt][i] *= rf_ * cf[i] + rb_ * cb[i]; \
        } else { \
          const int kbase = t * 64 - (isctx ? 0 : 256); \
          _Pragma("unroll") for (int i = 0; i < 16; ++i) { \
            const int df = iq - (kbase + kt * 32 + crow(i, h)); \
            const float e = __builtin_amdgcn_exp2f(df > 0 ? (float)df * lgf : (float)(-df) * lgb); \
            st[kt][i] *= (df == 0) ? 2.f : e; \
          } \
        } \
        _Pragma("unroll") for (int s = 0; s < 2; ++s) { \
          u32x4 pbu; \
          pbu[0] = pack2(st[kt][8 * s + 0], st[kt][8 * s + 1]); pbu[1] = pack2(st[kt][8 * s + 2], st[kt][8 * s + 3]); \
          pbu[2] = pack2(st[kt][8 * s + 4], st[kt][8 * s + 5]); pbu[3] = pack2(st[kt][8 * s + 6], st[kt][8 * s + 7]); \
          const bf16x8 pbv = __builtin_bit_cast(bf16x8, pbu); \
          _Pragma("unroll") for (int dt = 0; dt < 2; ++dt) { \
            const bf16x8 vfv = *(const bf16x8*)(v_ + (dt * 32 + r) * 72 + kt * 32 + s * 16 + 8 * h);     \
            O[mp][dt] = MFMA32(vfv, pbv, O[mp][dt]); \
          } \
        } \
      } \
      } }
    ATT_LOAD(x, 0);
    ATT_STORE(x, 0);
    __syncthreads();
    for (int tt = 0; tt < ntiles; ++tt) {
      const int cur = tt & 1;
      if (tt + 1 < ntiles) ATT_LOAD(x, tt + 1);
      ATT_COMPUTE(tt, cur);
      if (tt + 1 < ntiles) ATT_STORE(x, cur ^ 1);
      __syncthreads();
    }
#undef ATT_LOAD
#undef ATT_STORE
#undef ATT_COMPUTE
    if (KIND == 0) {
      const float inv = 1.f / (lsum[0] + __shfl_xor(lsum[0], 32));
#pragma unroll
      for (int dt = 0; dt < 2; ++dt)
#pragma unroll
        for (int i = 0; i < 16; ++i) o[dt][i] = O[0][dt][i] * inv;
    } else if (KIND == 1) {
      const float inv0 = 1.f / (lsum[0] + __shfl_xor(lsum[0], 32));
      const float inv1 = P.lamv[l * 2] / (lsum[NMAP - 1] + __shfl_xor(lsum[NMAP - 1], 32));
#pragma unroll
      for (int dt = 0; dt < 2; ++dt)
#pragma unroll
        for (int i = 0; i < 16; ++i) o[dt][i] = O[0][dt][i] * inv0 - O[NMAP - 1][dt][i] * inv1;
    } else {
#pragma unroll
      for (int dt = 0; dt < 2; ++dt)
#pragma unroll
        for (int i = 0; i < 16; ++i) o[dt][i] = O[0][dt][i];
    }
  }
  if (KIND == 1) {
    float ss = 0.f;
#pragma unroll
    for (int dt = 0; dt < 2; ++dt)
#pragma unroll
      for (int i = 0; i < 16; ++i) ss += o[dt][i] * o[dt][i];
    ss += __shfl_xor(ss, 32);
    const float sc = rsqrtf(ss * (1.f / 64.f) + 1e-6f) * (1.f - P.lamv[l * 2 + 1]);
#pragma unroll
    for (int dt = 0; dt < 2; ++dt)
#pragma unroll
      for (int i = 0; i < 16; ++i) o[dt][i] *= sc * P.diff_norm[l * 64 + dt * 32 + crow(i, h)];
  } else if (KIND == 2) {
    float s = 0.f;
#pragma unroll
    for (int dt = 0; dt < 2; ++dt)
#pragma unroll
      for (int i = 0; i < 16; ++i) s += o[dt][i];
    s += __shfl_xor(s, 32);
    const float mean = s * (1.f / 64.f);
    float q = 0.f;
#pragma unroll
    for (int dt = 0; dt < 2; ++dt)
#pragma unroll
      for (int i = 0; i < 16; ++i) { const float x = o[dt][i] - mean; o[dt][i] = x; q += x * x; }
    q += __shfl_xor(q, 32);
    const float rstd = rsqrtf(q * (1.f / 64.f) + 1e-5f);
#pragma unroll
    for (int dt = 0; dt < 2; ++dt)
#pragma unroll
      for (int g = 0; g < 4; ++g) {
        const int d0 = dt * 32 + 8 * g + 4 * h;
        const uint2 gt = *(const uint2*)(P.pbuf + (size_t)tq * INW + 3008 + hh * 64 + d0);
        const float g0 = bf2f((u16)(gt.x & 0xffff)), g1 = bf2f((u16)(gt.x >> 16)), g2 = bf2f((u16)(gt.y & 0xffff)), g3 = bf2f((u16)(gt.y >> 16));
        o[dt][4 * g + 0] *= rstd * g0 / (1.f + __expf(-g0));
        o[dt][4 * g + 1] *= rstd * g1 / (1.f + __expf(-g1));
        o[dt][4 * g + 2] *= rstd * g2 / (1.f + __expf(-g2));
        o[dt][4 * g + 3] *= rstd * g3 / (1.f + __expf(-g3));
      }
  }
#pragma unroll
  for (int dt = 0; dt < 2; ++dt)
#pragma unroll
    for (int g = 0; g < 4; ++g) {
      const int d0 = dt * 32 + 8 * g + 4 * h;
      uint2 w;
      w.x = pack2(o[dt][4 * g], o[dt][4 * g + 1]);
      w.y = pack2(o[dt][4 * g + 2], o[dt][4 * g + 3]);
      *(uint2*)(P.abuf + (size_t)tq * D + ycol + d0) = w;
    }
}

__device__ void phase_mixers(const Params& P, int l, unsigned char* smem, int cbase = 0, int mode = 0) {
  __shared__ int s_item;
  const int natt = (mode == 1 || mode == 3) ? 0 : 3072 + (l < NL - 1 ? 384 : 0);
  unsigned* qatt = P.counters + cbase + l;
  unsigned* qscan = P.counters + cbase + 16 + l;
  if (threadIdx.x == 0) {
    const unsigned key = xb_xcc_id() * 256u + ((unsigned)__builtin_amdgcn_s_getreg((6 << 11) | (8 << 6) | 4) & 0x7Fu);
    const unsigned slot = atomicAdd(P.cucnt + key, 1u);
    int it = -1;
    if ((slot & 1u) == 0u && mode != 2) { it = (int)atomicAdd(qscan, 1u); if (it >= 256) it = -1; }
    s_item = it;
  }
  __syncthreads();
  {
    const int it = s_item;
    __syncthreads();
    if (it >= 0) scan_item(P, l, it, smem, (mode == 3) ? (8 | SCAN_PM) : 0);
  }
  for (;;) {
    if (threadIdx.x == 0) s_item = (int)atomicAdd(qatt, 1u);
    __syncthreads();
    const int item = s_item;
    __syncthreads();
    if (item >= natt) break;
    int idx = item;
    int kind, b, hh, qb; bool isctx;
    if (idx < 3072) { kind = idx >> 10; kind = (kind == 0) ? 1 : (kind == 1 ? 0 : 2); int rem = idx & 1023; b = rem >> 6; hh = (rem >> 4) & 3; qb = rem & 15; isctx = false; }
    else { idx -= 3072; kind = idx >> 7; int rem = idx & 127; b = rem >> 3; hh = (rem >> 1) & 3; qb = rem & 1; isctx = true; }
    if (kind == 0) attn_item<0>(P, l, b, hh, qb, isctx, smem);
    else if (kind == 1) attn_item<1>(P, l, b, hh, qb, isctx, smem);
    else attn_item<2>(P, l, b, hh, qb, isctx, smem);
  }
  if (l + 1 < NL && mode == 0) {
    for (;;) {
      if (threadIdx.x == 0) s_item = (int)atomicAdd(P.counters + 24 + l, 1u);
      __syncthreads();
      const int t = s_item;
      __syncthreads();
      if (t >= NWCONV) break;
      wconv_tile(P, l + 1, t, smem);
    }
  }
  for (;;) {
    if (threadIdx.x == 0) s_item = (int)atomicAdd(qscan, 1u);
    __syncthreads();
    const int item = s_item;
    __syncthreads();
    if (item >= 256 || mode == 2 || mode == 3) break;
    scan_item(P, l, item, smem);
  }
}

__device__ void phase_rwkv_combine(const Params& P, int l, unsigned char* smem, int bid, int nb) {
  float* sg = (float*)smem;
  const int tid = opaque_tid(), wave = tid >> 6, c = tid;
  float gup[64];
#pragma unroll
  for (int r = 0; r < 64; ++r) gup[r] = P.rwkv_g_up[((size_t)(l * 64 + r)) * 256 + c];
  const float lng = P.rwkv_ln_g[l * 256 + c], lnb = P.rwkv_ln_b[l * 256 + c], mu_v = P.rwkv_mu[l * 960 + 512 + c];
  const float mu_g = P.rwkv_mu[l * 960 + 896 + (tid & 63)];
  const bool latent_only = (l == NL - 1);
  for (int tile = bid; tile < MALL / 16; tile += nb) {
    const int m0 = tile * 16, b = m0 / TALL, t0 = m0 - b * TALL;
    const bool isctx = t0 < CTX;
    if (latent_only && isctx) continue;
    const int seglo = b * TALL + (isctx ? 0 : CTX), seghi = b * TALL + (isctx ? CTX : TALL);
#pragma unroll
    for (int i = 0; i < 4; ++i) {
      const int idx = tid + 256 * i, tok = idx >> 6, r = idx & 63;
      const int m = m0 + tok;
      const u16* pp = P.pbuf + (size_t)m * INW + 896 + r;
      const float pc = bf2f(pp[0]);
      const float pm = (m - 1 >= seglo) ? bf2f(*(pp - INW)) : 0.f;
      const float pn = (m + 1 < seghi) ? bf2f(*(pp + INW)) : 0.f;
      const float ps = pc + mu_g * (0.5f * (pm + pn) - pc);
      sg[tok * 64 + r] = 1.f / (1.f + expf(-ps));
    }
    __syncthreads();
#pragma unroll 1
    for (int tq4 = 0; tq4 < 16; tq4 += 4) {
      float ya[4], yb[4], pcv[4], pmv[4], pnv[4], csa[4], csb[4];
#pragma unroll
      for (int u = 0; u < 4; ++u) {
        const int m = m0 + tq4 + u;
        ya[u] = bf2f(P.yd[((size_t)m) * 256 + c]); yb[u] = bf2f(P.yd[((size_t)(MALL + m)) * 256 + c]);
        const u16* pv = P.pbuf + (size_t)m * INW + 512 + c;
        pcv[u] = bf2f(pv[0]);
        pmv[u] = (m - 1 >= seglo) ? bf2f(*(pv - INW)) : 0.f;
        pnv[u] = (m + 1 < seghi) ? bf2f(*(pv + INW)) : 0.f;
        csa[u] = P.cbuf[((size_t)m) * 4 + wave]; csb[u] = P.cbuf[((size_t)(MALL + m)) * 4 + wave];
      }
#pragma unroll
      for (int u = 0; u < 4; ++u) {
        const int tok = tq4 + u, m = m0 + tok;
        float gacc = 0.f;
#pragma unroll
        for (int r = 0; r < 64; r += 4) {
          const float4 s4 = *(const float4*)(sg + tok * 64 + r);
          gacc += s4.x * gup[r] + s4.y * gup[r + 1] + s4.z * gup[r + 2] + s4.w * gup[r + 3];
        }
        const float y = ya[u] + yb[u];
        const float mean = wave_sum(y) * (1.f / 64.f);
        const float dd = y - mean;
        const float var = wave_sum(dd * dd) * (1.f / 64.f);
        const float yn = dd * rsqrtf(var + 64e-5f) * lng + lnb;
        const float vs = pcv[u] + mu_v * (0.5f * (pmv[u] + pnv[u]) - pcv[u]);
        P.abuf[(size_t)m * D + c] = f2bf((yn + (csa[u] + csb[u]) * vs) * gacc);
      }
    }
    __syncthreads();
  }
}

__device__ void run_phase(const Params& P, int ph, unsigned char* smem, int bid, int nb, const XcdBarrier* xbp) {
  if (ph == 1 + 9 * NL) { phase_prep(P, NL - 1, 2, bid, nb); return; }
  const int l = (ph - 1) / 9, s = (ph - 1) - l * 9;
  const bool last = (l == NL - 1);
  switch (s) {
    case 0:
      phase_prep(P, l, 0, bid, nb);
      if (l == 0) for (int t = bid; t < NWCONV; t += nb) wconv_tile(P, l, t, smem);
      break;
    case 1:
      phase_gemm<EPI_P, false>(P, l, P.abuf, P.w_in_t + (l & 1) * WIN_E, D, INWP / 128, smem, bid, nb);
#if PROBE == 1 || PROBE == 13
      phase_gemm<EPI_P, false>(P, l, P.abuf, P.w_in_t + (l & 1) * WIN_E, D, INWP / 128, smem, bid, nb);
#elif PROBE == 14
      phase_gemm<EPI_P, false>(P, l, P.abuf, P.w_in_t + (l & 1) * WIN_E, D, INWP / 128, smem, bid, nb, 2);
#elif PROBE == 15
      phase_gemm<EPI_P, false>(P, l, P.abuf, P.w_in_t + (l & 1) * WIN_E, D, INWP / 128, smem, bid, nb, 3);
#endif
      break;
    case 2:
      phase_attnprep(P, l, smem, bid, nb);
#if PROBE == 9
      phase_attnprep(P, l, smem, bid, nb, 1);
#endif
      break;
    case 3:
      phase_mixers(P, l, smem);
#if PROBE == 6
      xcd_barrier(*xbp);
      phase_mixers(P, l, smem, 32);
#elif PROBE == 2
      xcd_barrier(*xbp);
      phase_mixers(P, l, smem, 32, 1);
#elif PROBE == 3
      xcd_barrier(*xbp);
      phase_mixers(P, l, smem, 32, 2);
#elif PROBE == 8
      xcd_barrier(*xbp);
      phase_mixers(P, l, smem, 32, 3);
#endif
      break;
    case 4:
      phase_rwkv_combine(P, l, smem, bid, nb);
#if PROBE == 5
      phase_rwkv_combine(P, l, smem, bid, nb);
#endif
      break;
    case 5:
      if (last) phase_gemm<EPI_RES1, true>(P, l, P.abuf, P.w_out_t + (l & 1) * WOUT_E, D, D / 128, smem, bid, nb);
      else phase_gemm<EPI_RES1, false>(P, l, P.abuf, P.w_out_t + (l & 1) * WOUT_E, D, D / 128, smem, bid, nb);
#if PROBE == 11
      phase_gemm<EPI_RES1, false>(P, l, P.abuf, P.w_out_t + (l & 1) * WOUT_E, D, D / 128, smem, bid, nb, 1);
#endif
      break;
    case 6:
      phase_prep(P, l, 1, bid, nb);
#if PROBE == 10
      phase_prep(P, l, 1, bid, nb, 1);
#endif
      break;
    case 7:
      if (last) phase_gemm<EPI_SWIGLU, true>(P, l, P.abuf, P.ffn_in_t + (l & 1) * FIN_E, D, (2 * DFF) / 128, smem, bid, nb);
      else phase_gemm<EPI_SWIGLU, false>(P, l, P.abuf, P.ffn_in_t + (l & 1) * FIN_E, D, (2 * DFF) / 128, smem, bid, nb);
#if PROBE == 1
      phase_gemm<EPI_SWIGLU, false>(P, l, P.abuf, P.ffn_in_t + (l & 1) * FIN_E, D, (2 * DFF) / 128, smem, bid, nb);
#endif
      break;
    case 8:
      if (last) phase_gemm<EPI_RES2, true>(P, l, P.pbuf, P.ffn_out_t + (l & 1) * FOUT_E, DFF, D / 128, smem, bid, nb);
      else phase_gemm<EPI_RES2, false>(P, l, P.pbuf, P.ffn_out_t + (l & 1) * FOUT_E, DFF, D / 128, smem, bid, nb);
#if PROBE == 12
      phase_gemm<EPI_RES2, false>(P, l, P.pbuf, P.ffn_out_t + (l & 1) * FOUT_E, DFF, D / 128, smem, bid, nb, 1);
#elif PROBE == 16
      phase_gemm<EPI_RES2, false>(P, l, P.pbuf, P.ffn_out_t + (l & 1) * FOUT_E, DFF, D / 128, smem, bid, nb, 3);
#endif
      break;
  }
}

__global__ void __launch_bounds__(256, 2) fwd_megakernel(Params P, int ph_begin, int ph_end) {
  __shared__ __attribute__((aligned(16))) unsigned char smem[SMEM_BYTES];
  __shared__ uint4 xb_words;
  cg::grid_group grid = cg::this_grid();
  const int bid = blockIdx.x, nb = gridDim.x;
  if (threadIdx.x == 0) xb_words = make_uint4(0u, 0u, 0u, 0u);
  __syncthreads();
  (void)xcd_barrier_post(P.bar, (volatile LAS unsigned*)&xb_words);
  phase0(P, smem, bid, nb);
#if PROBE == 17
  phase0(P, smem, bid, nb);
#endif
  if (ph_end < 0) grid.sync();
  {
    XcdBarrier xb0; xb0.bar = P.bar; xb0.x = xb_xcc_id(); xb0.st = (volatile LAS unsigned*)&xb_words;
    xcd_barrier(xb0);
  }
  for (int ph = ph_begin + 1; ph < ph_end; ++ph) {
    XcdBarrier xb; xb.bar = P.bar; xb.x = xb_xcc_id(); xb.st = (volatile LAS unsigned*)&xb_words;
    run_phase(P, ph, smem, bid, nb, &xb);
    if (ph + 1 < ph_end) xcd_barrier(xb);
#if PROBE == 4
    xcd_barrier(xb); xcd_barrier(xb);
#endif
  }
}

extern "C" void kernel_launch(void* const* d_in, const int* in_sizes, int n_in, void* d_out, int out_size, void* d_ws,
                              size_t ws_size, hipStream_t stream) {
  Params P{};
  const float** pp = (const float**)&P;
  for (int i = 0; i < 29; ++i) pp[i] = (const float*)d_in[i];
  P.out = (float*)d_out;
  char* ws = (char*)d_ws;
  size_t off = 0;
  auto take = [&](size_t bytes) { char* p = ws + off; off += (bytes + 255) & ~(size_t)255; return p; };
  P.counters = (unsigned*)take(256);
  P.bar = (unsigned*)take(XCD_BAR_WORDS * 4);
  P.cucnt = (unsigned*)take(4096 * 4);
  P.lamv = (float*)take(256);
  P.mod = (float*)take((size_t)NL * 17 * 6144 * 4);
  P.ropeA = (float*)take(64 * 16 * 2 * 4);
  P.ropeD = (float*)take(64 * 8 * 2 * 4);
  P.ropeR = (float*)take(2048 * 32 * 2 * 4);
  P.cbuf = (float*)take((size_t)2 * MALL * 4 * 4);
  P.w_in_t = (u16*)take(WIN_E * 2 * 2);
  P.w_out_t = (u16*)take(WOUT_E * 2 * 2);
  P.ffn_in_t = (u16*)take(FIN_E * 2 * 2);
  P.ffn_out_t = (u16*)take(FOUT_E * 2 * 2);
  P.zctx = (float*)take((size_t)NBATCH * CTX * D * 4);
  P.pbuf = (u16*)take((size_t)MALL * INW * 2);
  P.abuf = (u16*)take((size_t)MALL * D * 2);
  P.yd = (u16*)take((size_t)2 * MALL * 256 * 2);
  P.vt = (u16*)take((size_t)NBATCH * 10 * 64 * TALL * 2);
  P.stats = (float*)take((size_t)MALL * 2 * 4);
  if (off > ws_size) fprintf(stderr, "workspace too small: need %zu have %zu\n", off, ws_size);

  static int grid_blocks = 0;
  if (!grid_blocks) {
    int dev = 0, cus = 0, per_cu = 0;
    (void)hipGetDevice(&dev);
    (void)hipDeviceGetAttribute(&cus, hipDeviceAttributeMultiprocessorCount, dev);
    (void)hipOccupancyMaxActiveBlocksPerMultiprocessor(&per_cu, fwd_megakernel, 256, 0);
    if (per_cu > 2) per_cu = 2;
    if (per_cu < 1) per_cu = 1;
    grid_blocks = cus * per_cu;
  }
  (void)hipMemsetAsync(P.counters, 0, 256 + XCD_BAR_WORDS * 4 + 4096 * 4, stream);
  int ph_begin = 0, ph_end = 2 + 9 * NL;
  void* args[] = {&P, &ph_begin, &ph_end};
  hipError_t e = hipLaunchCooperativeKernel((void*)fwd_megakernel, dim3(grid_blocks), dim3(256), args, 0, stream);
  if (e != hipSuccess) fprintf(stderr, "cooperative launch failed: %s (grid %d)\n", hipGetErrorString(e), grid_blocks);
}
```
